# Optimizing an MI355X kernel written in HIP

```python
import math
import jax, jax.numpy as jnp
from jax import lax
import numpy as np

D_MODEL = 2048
BATCH = 4
SEQ = 2048
DEPTH = 1

CHUNK = 64
EPS = 1e-6
MLA_HEADS = 8
QK_NOPE = 128
QK_ROPE = 64
V_HEAD = 128
Q_LORA = 512
KV_LORA = 512
ROPE_THETA = 10000.0
Q_BLOCK = 128
S5_CH = 1024
S5_GROUP = 16
S5_GROUPS = S5_CH // S5_GROUP
S5_STATE = 64
DT_MIN = 1e-3
DT_MAX = 1e-1
N_EXPERTS = 64
TOP_K = 6
N_EXPERT_GROUPS = 8
TOPK_GROUPS = 4
D_EXPERT = 512
D_SHARED = 512
ROUTED_SCALE = 2.5
EXPERT_BLOCK = 128

IN_SPLITS = [Q_LORA, Q_LORA + KV_LORA, Q_LORA + KV_LORA + QK_ROPE,
             Q_LORA + KV_LORA + QK_ROPE + S5_CH, Q_LORA + KV_LORA + QK_ROPE + S5_CH + D_MODEL]
IN_COLS = Q_LORA + KV_LORA + QK_ROPE + S5_CH + 2 * D_MODEL

kernel_name = "hybrid_mla_s5_moe_chunk_causal_block"


def rmsnorm(x, g):
    xf = x.astype(jnp.float32)
    y = xf * lax.rsqrt(jnp.mean(xf * xf, axis=-1, keepdims=True) + EPS)
    return (y * g.astype(jnp.float32)).astype(x.dtype)


def rope(x, cos, sin):
    x1, x2 = jnp.split(x, 2, axis=-1)
    return jnp.concatenate([x1 * cos - x2 * sin, x2 * cos + x1 * sin], axis=-1)


def mla(q_lat, kv_lat, k_pe_raw, positions, g_q, g_kv, w_uq, w_uk, w_uv):
    Bn, L, _ = q_lat.shape
    dt = q_lat.dtype
    q = (rmsnorm(q_lat, g_q) @ w_uq).reshape(Bn, L, MLA_HEADS, QK_NOPE + QK_ROPE)
    q_nope, q_pe = q[..., :QK_NOPE], q[..., QK_NOPE:]
    ckv = rmsnorm(kv_lat, g_kv)
    k_nope = (ckv @ w_uk).reshape(Bn, L, MLA_HEADS, QK_NOPE)
    v = (ckv @ w_uv).reshape(Bn, L, MLA_HEADS, V_HEAD)
    inv_freq = ROPE_THETA ** (-jnp.arange(QK_ROPE // 2, dtype=jnp.float32) / (QK_ROPE // 2))
    ang = positions.astype(jnp.float32)[..., None] * inv_freq
    cos, sin = jnp.cos(ang).astype(dt), jnp.sin(ang).astype(dt)
    q_pe = rope(q_pe, cos[:, :, None, :], sin[:, :, None, :])
    k_pe = rope(k_pe_raw, cos, sin)
    scale = (QK_NOPE + QK_ROPE) ** -0.5
    chunk_id = positions // CHUNK

    def block(i):
        s = i * Q_BLOCK
        qn = lax.dynamic_slice_in_dim(q_nope, s, Q_BLOCK, axis=1)
        qp = lax.dynamic_slice_in_dim(q_pe, s, Q_BLOCK, axis=1)
        qc = lax.dynamic_slice_in_dim(chunk_id, s, Q_BLOCK, axis=1)
        sc = (jnp.einsum('bqhd,bkhd->bhqk', qn, k_nope, preferred_element_type=jnp.float32)
              + jnp.einsum('bqhd,bkd->bhqk', qp, k_pe, preferred_element_type=jnp.float32)) * scale
        mask = chunk_id[:, None, :] <= qc[:, :, None]
        sc = jnp.where(mask[:, None], sc, jnp.float32(-1e30))
        p = jax.nn.softmax(sc, axis=-1).astype(v.dtype)
        return jnp.einsum('bhqk,bkhd->bqhd', p, v)

    out = lax.map(block, jnp.arange(L // Q_BLOCK))
    return jnp.moveaxis(out, 0, 1).reshape(Bn, L, MLA_HEADS * V_HEAD)


def s5(u, a_re, a_im, log_dt, b_re, b_im, c_re, c_im, d_skip, w_glu):
    Bn, L, _ = u.shape
    uf = u.astype(jnp.float32).reshape(Bn, L, S5_GROUPS, S5_GROUP)
    step = jnp.exp(log_dt.astype(jnp.float32))[:, None]
    ar, ai = a_re.astype(jnp.float32), a_im.astype(jnp.float32)
    mag = jnp.exp(ar * step)
    abar_re, abar_im = mag * jnp.cos(ai * step), mag * jnp.sin(ai * step)
    den = ar * ar + ai * ai
    nr, ni = abar_re - 1.0, abar_im
    f_re, f_im = (nr * ar + ni * ai) / den, (ni * ar - nr * ai) / den
    br, bi = b_re.astype(jnp.float32), b_im.astype(jnp.float32)
    bbar_re = f_re[..., None] * br - f_im[..., None] * bi
    bbar_im = f_re[..., None] * bi + f_im[..., None] * br
    bu_re = jnp.einsum('blgc,gpc->blgp', uf, bbar_re)
    bu_im = jnp.einsum('blgc,gpc->blgp', uf, bbar_im)
    a_re_t = jnp.broadcast_to(abar_re, bu_re.shape)
    a_im_t = jnp.broadcast_to(abar_im, bu_im.shape)

    def combine(e1, e2):
        a1r, a1i, b1r, b1i = e1
        a2r, a2i, b2r, b2i = e2
        return (a2r * a1r - a2i * a1i, a2r * a1i + a2i * a1r,
                a2r * b1r - a2i * b1i + b2r, a2r * b1i + a2i * b1r + b2i)

    _, _, xr, xi = lax.associative_scan(combine, (a_re_t, a_im_t, bu_re, bu_im), axis=1)
    y = (jnp.einsum('blgp,gcp->blgc', xr, c_re.astype(jnp.float32))
         - jnp.einsum('blgp,gcp->blgc', xi, c_im.astype(jnp.float32))
         + d_skip.astype(jnp.float32) * uf)
    y = jax.nn.gelu(y.reshape(Bn, L, S5_CH)).astype(u.dtype)
    return y * jax.nn.sigmoid(y @ w_glu)


def route(h, w_router, router_bias):
    N = h.shape[0]
    scores = jax.nn.sigmoid(jnp.einsum('nd,de->ne', h, w_router, preferred_element_type=jnp.float32))
    sel = scores + router_bias.astype(jnp.float32)
    grp = sel.reshape(N, N_EXPERT_GROUPS, N_EXPERTS // N_EXPERT_GROUPS)
    gscore = lax.top_k(grp, 2)[0].sum(-1)
    _, gidx = lax.top_k(gscore, TOPK_GROUPS)
    gmask = jnp.any(gidx[..., None] == jnp.arange(N_EXPERT_GROUPS), axis=-2)
    emask = jnp.repeat(gmask, N_EXPERTS // N_EXPERT_GROUPS, axis=-1)
    _, topi = lax.top_k(jnp.where(emask, sel, -jnp.inf), TOP_K)
    w = jnp.take_along_axis(scores, topi, axis=-1)
    w = w / jnp.sum(w, axis=-1, keepdims=True) * ROUTED_SCALE
    return topi, w.astype(h.dtype)


def routed_experts(xt, topi, topw, w_gate, w_up, w_down):
    N, D = xt.shape
    NK = N * TOP_K
    flat_e = topi.reshape(NK)
    flat_tok = jnp.repeat(jnp.arange(N, dtype=jnp.int32), TOP_K)
    flat_w = topw.reshape(NK)
    order = jnp.argsort(flat_e)
    se, stok, sw = flat_e[order], flat_tok[order], flat_w[order]
    counts = jnp.bincount(flat_e, length=N_EXPERTS)
    padded = (counts + EXPERT_BLOCK - 1) // EXPERT_BLOCK * EXPERT_BLOCK
    start = jnp.cumsum(counts) - counts
    pad_end = jnp.cumsum(padded)
    pad_start = pad_end - padded
    dest = pad_start[se] + jnp.arange(NK) - start[se]
    n_blocks = NK // EXPERT_BLOCK + N_EXPERTS
    P = n_blocks * EXPERT_BLOCK
    buf_tok = jnp.zeros((P,), jnp.int32).at[dest].set(stok)
    buf_w = jnp.zeros((P,), xt.dtype).at[dest].set(sw)
    blk_e = jnp.minimum(jnp.searchsorted(pad_end, jnp.arange(n_blocks) * EXPERT_BLOCK, side='right'),
                        N_EXPERTS - 1)

    def run(args):
        tok, e = args
        xb = xt[tok]
        return (jax.nn.silu(xb @ w_gate[e]) * (xb @ w_up[e])) @ w_down[e]

    y = lax.map(run, (buf_tok.reshape(n_blocks, EXPERT_BLOCK), blk_e)).reshape(P, D)
    return jnp.zeros_like(xt).at[buf_tok].add(y * buf_w[:, None].astype(y.dtype))


def setup_inputs(seed: int = 0) -> dict:
    key = jax.random.key(seed)
    ks = iter(jax.random.split(key, 48))
    f32 = jnp.float32

    def nrm(shape, scale):
        return jax.random.normal(next(ks), shape, f32) * scale

    def gain(shape):
        return 1.0 + nrm(shape, 0.05)

    G, P, Cg, Ld, D = S5_GROUPS, S5_STATE, S5_GROUP, DEPTH, D_MODEL
    x = nrm((BATCH, SEQ, D), 1.0)
    c = nrm((BATCH, D), 1.0)
    positions = (jax.random.randint(next(ks), (BATCH, 1), 0, 64, jnp.int32) * CHUNK
                 + jnp.arange(SEQ, dtype=jnp.int32)[None, :])
    return {
        "x": x, "c": c, "positions": positions,
        "w_ada": nrm((Ld, D, 6 * D), 0.5 * D ** -0.5),
        "b_ada": nrm((Ld, 6 * D), 0.01),
        "g_pre_mix": gain((Ld, D)), "g_post_mix": gain((Ld, D)),
        "g_pre_ffn": gain((Ld, D)), "g_post_ffn": gain((Ld, D)),
        "w_in": nrm((Ld, D, IN_COLS), D ** -0.5),
        "g_q": gain((Ld, Q_LORA)), "g_kv": gain((Ld, KV_LORA)),
        "w_uq": nrm((Ld, Q_LORA, MLA_HEADS * (QK_NOPE + QK_ROPE)), Q_LORA ** -0.5),
        "w_uk": nrm((Ld, KV_LORA, MLA_HEADS * QK_NOPE), KV_LORA ** -0.5),
        "w_uv": nrm((Ld, KV_LORA, MLA_HEADS * V_HEAD), KV_LORA ** -0.5),
        "a_re": -0.5 * jnp.exp(nrm((Ld, G, P), 0.05)),
        "a_im": jnp.pi * jnp.arange(P, dtype=f32) + nrm((Ld, G, P), 0.05),
        "log_dt": jax.random.uniform(next(ks), (Ld, G), f32, math.log(DT_MIN), math.log(DT_MAX)),
        "b_re": nrm((Ld, G, P, Cg), (2 * Cg) ** -0.5),
        "b_im": nrm((Ld, G, P, Cg), (2 * Cg) ** -0.5),
        "c_re": nrm((Ld, G, Cg, P), (2 * P) ** -0.5),
        "c_im": nrm((Ld, G, Cg, P), (2 * P) ** -0.5),
        "d_skip": nrm((Ld, G, Cg), 1.0),
        "w_glu": nrm((Ld, S5_CH, S5_CH), S5_CH ** -0.5),
        "w_br_mla": nrm((Ld, MLA_HEADS * V_HEAD, D), (MLA_HEADS * V_HEAD) ** -0.5),
        "w_br_s5": nrm((Ld, S5_CH, D), S5_CH ** -0.5),
        "w_out": nrm((Ld, D, D), D ** -0.5),
        "w_router": nrm((Ld, D, N_EXPERTS), D ** -0.5),
        "router_bias": nrm((Ld, N_EXPERTS), 0.01),
        "w_exp_gate": nrm((Ld, N_EXPERTS, D, D_EXPERT), D ** -0.5),
        "w_exp_up": nrm((Ld, N_EXPERTS, D, D_EXPERT), D ** -0.5),
        "w_exp_down": nrm((Ld, N_EXPERTS, D_EXPERT, D), D_EXPERT ** -0.5),
        "w_sh_gate": nrm((Ld, D, D_SHARED), D ** -0.5),
        "w_sh_up": nrm((Ld, D, D_SHARED), D ** -0.5),
        "w_sh_down": nrm((Ld, D_SHARED, D), D_SHARED ** -0.5),
    }


def reference(x, c, positions, w_ada, b_ada, g_pre_mix, g_post_mix, g_pre_ffn, g_post_ffn, w_in,
              g_q, g_kv, w_uq, w_uk, w_uv, a_re, a_im, log_dt, b_re, b_im, c_re, c_im, d_skip, w_glu,
              w_br_mla, w_br_s5, w_out, w_router, router_bias, w_exp_gate, w_exp_up, w_exp_down,
              w_sh_gate, w_sh_up, w_sh_down):
    Bn, L, D = x.shape
    for l in range(DEPTH):
        mod = (jax.nn.silu(c) @ w_ada[l] + b_ada[l])[:, None, :]
        sh1, sc1, gt1, sh2, sc2, gt2 = jnp.split(mod, 6, axis=-1)
        h = rmsnorm(x, g_pre_mix[l]) * (1.0 + sc1) + sh1
        q_lat, kv_lat, k_pe, u, gate_mla, gate_s5 = jnp.split(h @ w_in[l], IN_SPLITS, axis=-1)
        y_mla = mla(q_lat, kv_lat, k_pe, positions, g_q[l], g_kv[l], w_uq[l], w_uk[l], w_uv[l]) @ w_br_mla[l]
        y_s5 = s5(u, a_re[l], a_im[l], log_dt[l], b_re[l], b_im[l], c_re[l], c_im[l], d_skip[l],
                  w_glu[l]) @ w_br_s5[l]
        mixed = (jax.nn.sigmoid(gate_mla) * y_mla + jax.nn.sigmoid(gate_s5) * y_s5) @ w_out[l]
        x = x + gt1 * rmsnorm(mixed, g_post_mix[l])
        h = (rmsnorm(x, g_pre_ffn[l]) * (1.0 + sc2) + sh2).reshape(Bn * L, D)
        topi, topw = route(h, w_router[l], router_bias[l])
        shared = (jax.nn.silu(h @ w_sh_gate[l]) * (h @ w_sh_up[l])) @ w_sh_down[l]
        ffn = routed_experts(h, topi, topw, w_exp_gate[l], w_exp_up[l], w_exp_down[l]) + shared
        x = x + gt2 * rmsnorm(ffn.reshape(Bn, L, D), g_post_ffn[l])
    return x
```

```cpp
#include <hip/hip_runtime.h>
#include <cstdio>
#include <cstdint>

#ifndef MK_ONE_LAUNCH
#define MK_ONE_LAUNCH 1
#endif

#define GAS __attribute__((address_space(1)))
#define LAS __attribute__((address_space(3)))
typedef unsigned short bf16;
typedef float f32x4 __attribute__((ext_vector_type(4)));
typedef float f32x2 __attribute__((ext_vector_type(2)));
typedef unsigned u32x4 __attribute__((ext_vector_type(4)));
typedef unsigned u32x2 __attribute__((ext_vector_type(2)));
typedef short bf16x8 __attribute__((ext_vector_type(8)));

constexpr int NB = 4, SEQ = 2048, DM = 2048, NTOK = NB * SEQ;
constexpr int NH = 8, DNOPE = 128, DROPE = 64, DQK = 192, DV = 128, QLORA = 512, KVLORA = 512;
constexpr int S5CH = 1024, S5G = 64, S5P = 64, S5GC = 16;
constexpr int NE = 64, TOPK = 6, NEG = 8, TOPG = 4, DE = 512;
constexpr int INC = 6208, N1 = 6144;
constexpr float EPS = 1e-6f;
constexpr float QSCALE = 0.07216878364870322f * 1.4426950408889634f;
constexpr int NWAVES = 8, NTHR = 512;
constexpr int SCH = 64, NCHUNK = SEQ / SCH;

constexpr size_t MiB = 1u << 20;
constexpr size_t WS_CTL = 0, CTL_ZERO_BYTES = 65536;
constexpr size_t WS_MOD = 1 * MiB;
constexpr size_t WS_S5P = 2 * MiB;
constexpr size_t WS_ROPE = 3 * MiB;
constexpr size_t WS_TILEC = 5 * MiB;
constexpr size_t WS_S5E = 6 * MiB;
constexpr size_t WS_RSS = 10 * MiB;
constexpr size_t WS_ROWTOK = 11 * MiB;
constexpr size_t WS_TOKINFO = 13 * MiB;
constexpr size_t WS_S5BF = 14 * MiB;
constexpr size_t WS_WIN = 16 * MiB, WS_WPE = 40 * MiB, WS_WUQ = 41 * MiB, WS_WUKV = 43 * MiB, WS_WGLU = 45 * MiB, WS_WBRM = 47 * MiB, WS_WBRS = 51 * MiB,
                 WS_WOUT = 55 * MiB, WS_WR = 63 * MiB, WS_WGU = 64 * MiB, WS_WD = 324 * MiB;
constexpr size_t WS_H = 454 * MiB, WS_ACT = 486 * MiB, WS_ACTS = 550 * MiB, WS_YS = 558 * MiB, WS_BIG = 590 * MiB;
constexpr size_t WS_QL = WS_BIG, WS_KVL = WS_BIG + 8 * MiB, WS_U = WS_BIG + 16 * MiB, WS_SGM = WS_BIG + 32 * MiB, WS_SGS = WS_BIG + 64 * MiB, WS_Q = WS_BIG + 96 * MiB,
                 WS_KN = WS_BIG + 120 * MiB, WS_KPE = WS_BIG + 136 * MiB, WS_VT = WS_BIG + 137 * MiB, WS_AO = WS_BIG + 153 * MiB, WS_YG = WS_BIG + 169 * MiB,
                 WS_S5O = WS_BIG + 185 * MiB, WS_M1 = WS_BIG + 201 * MiB, WS_MIXED = WS_BIG + 233 * MiB, WS_H2LO = WS_BIG + 297 * MiB;
constexpr size_t WS_Y = WS_BIG;
constexpr size_t WS_END = WS_BIG + 329 * MiB;
static_assert(WS_Y + 256 * MiB <= WS_H2LO, "Y overlay must not reach H2LO... (H2LO is dead by P10 anyway)");

constexpr int CW_TMO = 0, CW_BAR = 4096, CW_CNT = 8192;

constexpr int LDS_BYTES = 147456;
constexpr int MISC_OFF = 131072 + 8192;

__device__ __forceinline__ float bf2f(unsigned h) { return __uint_as_float(h << 16); }
__device__ __forceinline__ unsigned f2bf(float f) { unsigned u = __float_as_uint(f); return (u + 0x7fffu + ((u >> 16) & 1u)) >> 16; }
__device__ __forceinline__ unsigned pk2(float lo, float hi) { unsigned r; asm("v_cvt_pk_bf16_f32 %0, %1, %2" : "=v"(r) : "v"(lo), "v"(hi)); return r; }
__device__ __forceinline__ float wave_sum(float v) {
#pragma unroll
    for (int o = 1; o < 64; o <<= 1) v += __shfl_xor(v, o);
    return v;
}
__device__ __forceinline__ float sigm(float x) { return __builtin_amdgcn_rcpf(1.0f + __builtin_amdgcn_exp2f(-1.4426950408889634f * x)); }
__device__ __forceinline__ void unpack8(const u32x4 w, float (&f)[8]) {
    f[0] = __uint_as_float(w.x << 16); f[1] = __uint_as_float(w.x & 0xffff0000u); f[2] = __uint_as_float(w.y << 16); f[3] = __uint_as_float(w.y & 0xffff0000u);
    f[4] = __uint_as_float(w.z << 16); f[5] = __uint_as_float(w.z & 0xffff0000u); f[6] = __uint_as_float(w.w << 16); f[7] = __uint_as_float(w.w & 0xffff0000u);
}
__device__ __forceinline__ u32x4 pack8(const float (&f)[8]) { u32x4 w; w.x = pk2(f[0], f[1]); w.y = pk2(f[2], f[3]); w.z = pk2(f[4], f[5]); w.w = pk2(f[6], f[7]); return w; }
__device__ __forceinline__ float clamp448(float x) { return fminf(fmaxf(x, -448.f), 448.f); }
__device__ __forceinline__ unsigned pk4_fp8(float a, float b, float c, float d) {
    int p = 0; p = __builtin_amdgcn_cvt_pk_fp8_f32(clamp448(a), clamp448(b), p, false); p = __builtin_amdgcn_cvt_pk_fp8_f32(clamp448(c), clamp448(d), p, true); return (unsigned)p; }
constexpr float GU_WSCALE = 64.f, DN_WSCALE = 32.f, ACT_SCALE = 8.f, Y_SCALE = 16.f;
constexpr int E8_GU_W = 127 - 6, E8_DN_W = 127 - 5, E8_ACT = 127 - 3, E8_ONE = 127;
#define LDS_WAIT() asm volatile("s_waitcnt lgkmcnt(0)" ::: "memory")
#define VM_WAIT() asm volatile("s_waitcnt vmcnt(0)" ::: "memory")

#define XB_TMO      128
#define XB_XCNT(j)  (256  + 64 * (j))
#define XB_XSUB(j)  (1280 + 64 * (j))
#define XB_XGEN(j)  (2304 + 64 * (j))
#define XB_TOP      3328
#define XB_TOPGEN   3392
#define XCD_BAR_WORDS 3456
#define XB_SPIN_CAP (1u << 18)
__device__ __forceinline__ unsigned xb_ld(unsigned* p)              { return __hip_atomic_load(p, __ATOMIC_RELAXED, __HIP_MEMORY_SCOPE_AGENT); }
__device__ __forceinline__ unsigned xb_add(unsigned* p, unsigned v) { return __hip_atomic_fetch_add(p, v, __ATOMIC_RELAXED, __HIP_MEMORY_SCOPE_AGENT); }
__device__ __forceinline__ unsigned xb_xcc_id() { return (unsigned)__builtin_amdgcn_s_getreg((3 << 11) | 20) & 0xFu; }
#define XB_SPIN(cond, bar) do { unsigned _sp = 0; while (cond) { __builtin_amdgcn_s_sleep(1); \
    if ((++_sp & 255u) == 0u) { if (xb_ld(&(bar)[XB_TMO])) break; if (_sp > XB_SPIN_CAP) { atomicAdd(&(bar)[XB_TMO], 1u); break; } } } } while (0)
struct XcdBarrier { unsigned* bar; unsigned x; volatile LAS unsigned* st; };
__device__ __forceinline__ XcdBarrier xcd_barrier_post(unsigned* bar, volatile LAS unsigned* st) {
    XcdBarrier b; b.bar = bar; b.x = xb_xcc_id(); b.st = st;
    if (threadIdx.x == 0) (void)xb_add(&bar[XB_XCNT(b.x)], 1u);
    return b;
}
__device__ __forceinline__ void xcd_barrier_complete(unsigned* bar, unsigned x, unsigned& nloc, unsigned& nx) {
    const unsigned G = gridDim.x * gridDim.y * gridDim.z;
    unsigned sum, cnt, mine, sp = 0u;
    for (;;) {
        sum = 0u; cnt = 0u; mine = 0u;
#pragma unroll
        for (unsigned j = 0; j < 16; ++j) { const unsigned c = xb_ld(&bar[XB_XCNT(j)]); sum += c; cnt += (c > 0u) ? 1u : 0u; mine = (j == x) ? c : mine; }
        if (sum == G) break;
        __builtin_amdgcn_s_sleep(1);
        if ((++sp & 255u) == 0u) { if (xb_ld(&bar[XB_TMO])) break; if (sp > XB_SPIN_CAP) { atomicAdd(&bar[XB_TMO], 1u); break; } }
    }
    nloc = mine > 0u ? mine : 1u; nx = cnt > 0u ? cnt : 1u;
}
__device__ __forceinline__ void xcd_barrier(const XcdBarrier& b) {
    asm volatile("s_waitcnt vmcnt(0)" ::: "memory");
    __syncthreads();
    if (threadIdx.x == 0) {
        unsigned* bar = b.bar;
        __builtin_amdgcn_s_waitcnt(0);
        unsigned nloc = b.st[0], nx = b.st[1];
        if (nloc == 0u) { xcd_barrier_complete(bar, b.x, nloc, nx); b.st[0] = nloc; b.st[1] = nx; }
        const unsigned old = xb_add(&bar[XB_XSUB(b.x)], 1u);
        const unsigned gen = old / nloc;
        if (old + 1u == (gen + 1u) * nloc) {
            __builtin_amdgcn_fence(__ATOMIC_RELEASE, "agent");
            asm volatile("s_waitcnt vmcnt(0)" ::: "memory");
            const unsigned og = xb_add(&bar[XB_TOP], 1u);
            const unsigned tg = og / nx;
            if (og + 1u == (tg + 1u) * nx) xb_add(&bar[XB_TOPGEN], 1u);
            else XB_SPIN(xb_ld(&bar[XB_TOPGEN]) == tg, bar);
            __builtin_amdgcn_fence(__ATOMIC_ACQUIRE, "agent");
            xb_add(&bar[XB_XGEN(b.x)], 1u);
            asm volatile("s_waitcnt vmcnt(0)" ::: "memory");
        } else {
            XB_SPIN(xb_ld(&bar[XB_XGEN(b.x)]) == gen, bar);
            __builtin_amdgcn_fence(__ATOMIC_ACQUIRE, "agent");
            asm volatile("s_waitcnt vmcnt(0)" ::: "memory");
        }
    }
    __syncthreads();
}

struct Args { const void* in[35]; float* out; unsigned char* ws; int ph_lo, ph_hi; };
struct Frame {
    LAS unsigned char* lds;
    unsigned char* ws;
    const void* const* in;
    float* out;
    int tid, lane, wave, G, bid, vcu;
};
#define INF(k) ((const float*)F.in[k])
#define WSP(T, off) ((T*)(F.ws + (off)))

struct TSeg { const float* src; int ldn; int K; bf16* dst; const float* kscale; int perm; int kt; int fp8; float wscale; };
__device__ __forceinline__ void tt_load(const TSeg& s, f32x4 (&v)[16], int lane) {
    const int k0 = s.kt * 64;
#pragma unroll
    for (int j = 0; j < 16; ++j) { const int k = 4 * j + (lane >> 4), n4 = lane & 15; v[j] = __builtin_nontemporal_load((const f32x4*)(s.src + (size_t)(k0 + k) * s.ldn + 4 * n4)); }
}
struct TPend { unsigned char* d; int K; int have; };
__device__ __forceinline__ void tt_flush(const TPend& pp, const u32x2 (&pk)[8], int lane) {
    unsigned char* d8 = pp.d + (size_t)(lane >> 3) * pp.K + 8 * (lane & 7); const size_t st = (size_t)8 * pp.K;
#pragma unroll
    for (int j = 0; j < 8; ++j) asm volatile("global_store_dwordx2 %0, %1, off nt" : : "v"(d8 + j * st), "v"(pk[j]) : "memory");
}
template <bool EXPERT>
__device__ __forceinline__ void tt_finish(const TSeg& s, const f32x4 (&v)[16], LAS float* scr, int lane, TPend& pp, u32x2 (&pkh)[8]) {
    const int k0 = s.kt * 64;
    const float* kscale = EXPERT ? nullptr : s.kscale; const int perm = EXPERT ? 0 : s.perm; const int isfp8 = EXPERT ? 1 : s.fp8;
#pragma unroll
    for (int j = 0; j < 16; ++j) { const int k = 4 * j + (lane >> 4), n4 = lane & 15;
        f32x4 w = v[j]; if (kscale) w = w * kscale[k0 + k];
        *(LAS f32x4*)(scr + k * 64 + ((n4 ^ ((k >> 3) & 7)) << 2)) = w; }
    LDS_WAIT();
    if constexpr (EXPERT) { if (pp.have) tt_flush(pp, pkh, lane); }
    const int c = lane & 7;
#pragma unroll
    for (int j = 0; j < 8; ++j) {
        const int nn = (lane >> 3) + 8 * j;
        int ns = nn; if (perm) { const int a = nn >> 3, b = nn & 7; ns = (b < 4) ? (4 * a + b) : (32 + 4 * a + (b - 4)); }
        float f[8];
#pragma unroll
        for (int i = 0; i < 8; ++i) { const int k = 8 * c + i; f[i] = scr[k * 64 + ((((ns >> 2) ^ c) & 15) << 2) + (ns & 3)]; }
        if (isfp8) { const float w = s.wscale;
            const u32x2 pk = (u32x2){pk4_fp8(f[0] * w, f[1] * w, f[2] * w, f[3] * w), pk4_fp8(f[4] * w, f[5] * w, f[6] * w, f[7] * w)};
            if constexpr (EXPERT) pkh[j] = pk;
            else { unsigned char* d8 = (unsigned char*)s.dst + (size_t)nn * s.K + k0 + 8 * c; asm volatile("global_store_dwordx2 %0, %1, off nt" : : "v"(d8), "v"(pk) : "memory"); } }
        else { const u32x4 pk = pack8(f); bf16* d = s.dst + (size_t)nn * s.K + k0 + 8 * c;
            asm volatile("global_store_dwordx4 %0, %1, off nt\n\ts_nop 1" : : "v"(d), "v"(pk) : "memory"); }
    }
    if constexpr (EXPERT) { pp.d = (unsigned char*)s.dst + k0; pp.K = s.K; pp.have = 1; }
    LDS_WAIT();
}
constexpr int T_IN_A = 16 * 32, T_IN_B = 80 * 32, T_PE = 32, T_UQ = 24 * 8, T_UK = 16 * 8, T_UV = 16 * 8, T_GLU = 16 * 16, T_BRM = 32 * 16, T_BRS = 32 * 16, T_OUT = 32 * 32,
              T_GU1 = 16 * 32, T_GU = 65 * T_GU1, T_D1 = 32 * 8, T_D = 65 * T_D1;
constexpr int ODD_SHARE_PM = 565;
constexpr int T_TOTAL = T_IN_A + T_IN_B + T_PE + T_UQ + T_UK + T_UV + T_GLU + T_BRM + T_BRS + T_OUT + T_GU + T_D;
__device__ __forceinline__ void tile_desc(Frame& F, int it, TSeg& s) {
    int r = it; s.kscale = nullptr; s.perm = 0; s.fp8 = 0; s.wscale = 1.f; int kt;
    if (r < T_GU) {
        const int e = r / T_GU1, q = r % T_GU1, j16 = q & 15; kt = q >> 4;
        const int isup = j16 >> 3, pn = (j16 & 7) >> 1, c64 = j16 & 1, nt = pn * 4 + isup * 2 + c64;
        const float* srcm = (e < NE) ? (isup ? INF(30) : INF(29)) + (size_t)e * DM * DE : (isup ? INF(33) : INF(32));
        s.src = srcm + 128 * pn + 64 * c64; s.ldn = DE; s.K = DM; s.fp8 = 1; s.wscale = GU_WSCALE; s.dst = (bf16*)(WSP(unsigned char, WS_WGU) + (size_t)e * 1024 * DM + (size_t)(nt * 64) * DM);
    } else if ((r -= T_GU) < T_D) {
        const int e = r / T_D1, q = r % T_D1, nt = q & 31; kt = q >> 5;
        const float* srcm = (e < NE) ? INF(31) + (size_t)e * DE * DM : INF(34);
        s.src = srcm + 64 * nt; s.ldn = DM; s.K = DE; s.fp8 = 1; s.wscale = DN_WSCALE; s.dst = (bf16*)(WSP(unsigned char, WS_WD) + (size_t)e * DM * DE + (size_t)(nt * 64) * DE);
    } else if ((r -= T_D) < T_IN_A) { const int nt = r / 32; kt = r % 32; s.src = INF(9) + 64 * nt; s.ldn = INC; s.K = DM; s.dst = WSP(bf16, WS_WIN) + (size_t)(nt * 64) * DM; }
    else if ((r -= T_IN_A) < T_IN_B) { const int nt = r / 32; kt = r % 32; s.src = INF(9) + 1088 + 64 * nt; s.ldn = INC; s.K = DM;
        if (nt < 16) s.dst = WSP(bf16, WS_WIN) + (size_t)(1024 + nt * 64) * DM;
        else { s.fp8 = 1; s.wscale = GU_WSCALE; s.dst = (bf16*)(WSP(unsigned char, WS_H2LO) + 16 * MiB + (size_t)((nt - 16) * 64) * DM); } }
    else if ((r -= T_IN_B) < T_PE) { kt = r; s.src = INF(9) + 1024; s.ldn = INC; s.K = DM; s.dst = WSP(bf16, WS_WPE); }
    else if ((r -= T_PE) < T_UQ) { const int nt = r / 8; kt = r % 8; s.src = INF(12) + 64 * nt; s.ldn = 1536; s.K = QLORA; s.dst = WSP(bf16, WS_WUQ) + (size_t)(nt * 64) * QLORA; s.kscale = INF(10); s.perm = ((nt % 3) == 2); }
    else if ((r -= T_UQ) < T_UK) { const int nt = r / 8; kt = r % 8; s.src = INF(13) + 64 * nt; s.ldn = 1024; s.K = KVLORA; s.dst = WSP(bf16, WS_WUKV) + (size_t)(nt * 64) * KVLORA; s.kscale = INF(11); }
    else if ((r -= T_UK) < T_UV) { const int nt = r / 8; kt = r % 8; s.src = INF(14) + 64 * nt; s.ldn = 1024; s.K = KVLORA; s.dst = WSP(bf16, WS_WUKV) + (size_t)(1024 + nt * 64) * KVLORA; s.kscale = INF(11); }
    else if ((r -= T_UV) < T_GLU) { const int nt = r / 16; kt = r % 16; s.src = INF(23) + 64 * nt; s.ldn = 1024; s.K = 1024; s.dst = WSP(bf16, WS_WGLU) + (size_t)(nt * 64) * 1024; }
    else if ((r -= T_GLU) < T_BRM) { const int nt = r / 16; kt = r % 16; s.src = INF(24) + 64 * nt; s.ldn = DM; s.K = 1024; s.dst = WSP(bf16, WS_WBRM) + (size_t)(nt * 64) * 1024; }
    else if ((r -= T_BRM) < T_BRS) { const int nt = r / 16; kt = r % 16; s.src = INF(25) + 64 * nt; s.ldn = DM; s.K = 1024; s.dst = WSP(bf16, WS_WBRS) + (size_t)(nt * 64) * 1024; }
    else { r -= T_BRS; const int nt = r / 32; kt = r % 32; s.src = INF(26) + 64 * nt; s.ldn = DM; s.K = DM; s.dst = WSP(bf16, WS_WOUT) + (size_t)(nt * 64) * DM; }
    s.kt = kt;
}
template <bool EXPERT>
__device__ __forceinline__ void p0_transposes(Frame& F) {
    LAS float* scr = (LAS float*)(F.lds + F.wave * 16384);
    int it, end, NGW;
    if constexpr (EXPERT) {
        const int TT = T_GU + T_D, n_odd = F.G / 2, n_even = F.G - n_odd, T_ODD = n_odd ? (int)((long)TT * ODD_SHARE_PM / 1000) : 0;
        if (F.vcu & 1) { it = (F.vcu >> 1) * NWAVES + F.wave; end = T_ODD; NGW = n_odd * NWAVES; } else { it = T_ODD + (F.vcu >> 1) * NWAVES + F.wave; end = TT; NGW = n_even * NWAVES; }
    } else { it = T_GU + T_D + F.vcu * NWAVES + F.wave; end = T_TOTAL; NGW = F.G * NWAVES; }
    TSeg sa, sb; f32x4 va[16], vb[16]; TPend pp{nullptr, 0, 0}; u32x2 pk[8];
    if (it >= end) return;
    tile_desc(F, it, sa); tt_load(sa, va, F.lane);
    while (it + 2 * NGW < end) {
        tile_desc(F, it + NGW, sb); tt_load(sb, vb, F.lane);
        tt_finish<EXPERT>(sa, va, scr, F.lane, pp, pk);
        tile_desc(F, it + 2 * NGW, sa); tt_load(sa, va, F.lane);
        tt_finish<EXPERT>(sb, vb, scr, F.lane, pp, pk);
        it += 2 * NGW;
    }
    if (it + NGW < end) { tile_desc(F, it + NGW, sb); tt_load(sb, vb, F.lane); tt_finish<EXPERT>(sa, va, scr, F.lane, pp, pk); tt_finish<EXPERT>(sb, vb, scr, F.lane, pp, pk); }
    else tt_finish<EXPERT>(sa, va, scr, F.lane, pp, pk);
    if constexpr (EXPERT) tt_flush(pp, pk, F.lane);
}
__device__ __forceinline__ void p0_small(Frame& F) {
    const int gt = F.bid + F.G * F.tid, NGT = F.G * NTHR;
    { bf16* hi = WSP(bf16, WS_WR); bf16* lo = hi + 64 * DM; const float* wr = INF(27);
      for (int i = gt; i < 64 * DM; i += NGT) { const int e = i >> 11, k = i & 2047; const float w = wr[(size_t)k * 64 + e]; const unsigned h = f2bf(w); hi[i] = (bf16)h; lo[i] = (bf16)f2bf(w - bf2f(h)); } }
    { f32x2* cs = WSP(f32x2, WS_ROPE); const int* pos = (const int*)F.in[2];
      for (int i = gt; i < NTOK * 32; i += NGT) { const int t = i >> 5, j = i & 31;
          const float invf = (float)pow(10000.0, -(double)j / 32.0); const float ang = (float)pos[t] * invf; const double a = (double)ang;
          cs[i] = (f32x2){(float)cos(a), (float)sin(a)}; } }
    { int* tc = WSP(int, WS_TILEC); const int* pos = (const int*)F.in[2];
      for (int i = gt; i < NB * 32; i += NGT) { int mn = 0x7fffffff, mx = -0x7fffffff - 1;
          for (int j = 0; j < 64; ++j) { const int c = pos[i * 64 + j] >> 6; mn = c < mn ? c : mn; mx = c > mx ? c : mx; } tc[i] = mn; tc[128 + i] = mx; } }
    { bf16* bf = WSP(bf16, WS_S5BF);
      for (int i = gt; i < S5G * 8 * 64; i += NGT) { const int lane = i & 63, nb = (i >> 6) & 7, g = i >> 9; const int n = 16 * nb + (lane & 15), p = n & 63, im = n >> 6, kq = lane >> 4;
          const int gp = g * 64 + p; const double step = exp((double)INF(17)[g]), ar = (double)INF(15)[gp], ai = (double)INF(16)[gp];
          const double mag = exp(ar * step), are = mag * cos(ai * step), aim = mag * sin(ai * step);
          const double den = ar * ar + ai * ai, nr = are - 1.0, ni = aim, fre = (nr * ar + ni * ai) / den, fim = (ni * ar - nr * ai) / den;
          float f[8];
#pragma unroll
          for (int j = 0; j < 8; ++j) { const int c = 8 * (kq & 1) + j; const double br = (double)INF(18)[(size_t)gp * 16 + c], bi = (double)INF(19)[(size_t)gp * 16 + c];
              const float v = (float)(im ? (fre * bi + fim * br) : (fre * br - fim * bi)); const float hi = bf2f(f2bf(v)); f[j] = (kq < 2) ? hi : (v - hi); }
          *(u32x4*)(bf + (size_t)i * 8) = pack8(f); } }
    { f32x2* abar = WSP(f32x2, WS_S5P); f32x2* apow = abar + 4096; f32x2* bbar = abar + 8192;
      for (int i = gt; i < S5G * S5P; i += NGT) { const int g = i >> 6;
          const double step = exp((double)INF(17)[g]), ar = (double)INF(15)[i], ai = (double)INF(16)[i];
          const double mag = exp(ar * step), are = mag * cos(ai * step), aim = mag * sin(ai * step);
          const double den = ar * ar + ai * ai, nr = are - 1.0, ni = aim, fre = (nr * ar + ni * ai) / den, fim = (ni * ar - nr * ai) / den;
          abar[i] = (f32x2){(float)are, (float)aim};
          double pr = are, pi = aim;
#pragma unroll 1
          for (int s = 0; s < 6; ++s) { const double tr = pr * pr - pi * pi, ti = 2.0 * pr * pi; pr = tr; pi = ti; }
          apow[i] = (f32x2){(float)pr, (float)pi};
          { double qr = pr, qi = pi;
#pragma unroll 1
            for (int s2 = 0; s2 < 2; ++s2) { const double tr = qr * qr - qi * qi, ti = 2.0 * qr * qi; qr = tr; qi = ti; }
            abar[73728 + i] = (f32x2){(float)qr, (float)qi}; }
#pragma unroll 1
          for (int c = 0; c < S5GC; ++c) { const double br = (double)INF(18)[(size_t)i * 16 + c], bi = (double)INF(19)[(size_t)i * 16 + c];
              bbar[(size_t)i * 16 + c] = (f32x2){(float)(fre * br - fim * bi), (float)(fre * bi + fim * br)}; } } }
}
__device__ __forceinline__ void p0_mod(Frame& F) {
    LAS float* sc = (LAS float*)F.lds;
    LAS float* red = sc + 8192;
    const float* cc = INF(1); const float* wa = INF(3); const float* ba = INF(4); float* mod = WSP(float, WS_MOD);
    for (int i = F.tid; i < NB * DM; i += NTHR) { const float x = cc[i]; sc[i] = x / (1.0f + expf(-x)); }
    __syncthreads();
    for (int ch = F.bid; ch < 256; ch += F.G) {
        const int col0 = ch * 48;
        if (F.tid < 504) {
            const int q = F.tid % 12, r = F.tid / 12;
            f32x4 acc[4]; for (int b = 0; b < 4; ++b) acc[b] = (f32x4){0.f, 0.f, 0.f, 0.f};
            for (int k0 = r; k0 < DM; k0 += 42 * 7) { f32x4 w[7];
#pragma unroll
                for (int u7 = 0; u7 < 7; ++u7) { const int k = k0 + 42 * u7; w[u7] = (k < DM) ? *(const f32x4*)(wa + (size_t)k * 12288 + col0 + 4 * q) : (f32x4){0.f, 0.f, 0.f, 0.f}; }
#pragma unroll
                for (int u7 = 0; u7 < 7; ++u7) { const int k = k0 + 42 * u7; if (k < DM) {
#pragma unroll
                    for (int b = 0; b < 4; ++b) acc[b] += w[u7] * sc[b * DM + k]; } } }
#pragma unroll
            for (int b = 0; b < 4; ++b) *(LAS f32x4*)(red + r * 192 + b * 48 + 4 * q) = acc[b];
        }
        __syncthreads();
        if (F.tid < 192) { float s = 0.f; for (int r = 0; r < 42; ++r) s += red[r * 192 + F.tid]; const int b = F.tid / 48, cl = F.tid % 48; mod[b * 12288 + col0 + cl] = s + ba[col0 + cl]; }
        __syncthreads();
    }
}

__device__ __forceinline__ void p1_row(Frame& F, const f32x4 (&v)[8], int m) {
    const float* g = INF(5); const float* mod = WSP(float, WS_MOD); bf16* H = WSP(bf16, WS_H);
    const int b = m / SEQ; const float* sh = mod + b * 12288; const float* scl = sh + DM;
    f32x4 gg[8], s1[8], s0[8];
#pragma unroll
    for (int j = 0; j < 8; ++j) { const int k = 4 * F.lane + 256 * j; gg[j] = *(const f32x4*)(g + k); s1[j] = *(const f32x4*)(scl + k); s0[j] = *(const f32x4*)(sh + k); }
    float s = 0.f;
#pragma unroll
    for (int j = 0; j < 8; ++j) s += (v[j].x * v[j].x + v[j].y * v[j].y) + (v[j].z * v[j].z + v[j].w * v[j].w);
    const float rs = 1.0f / sqrtf(wave_sum(s) * (1.0f / DM) + EPS);
    u32x2* o = (u32x2*)(H + (size_t)m * DM) + F.lane; unsigned* o8 = (unsigned*)(WSP(unsigned char, WS_H2LO) + (size_t)m * DM) + F.lane;
#pragma unroll
    for (int j = 0; j < 8; ++j) { const f32x4 h = v[j] * rs * gg[j] * (1.0f + s1[j]) + s0[j];
        { const u32x2 hv = (u32x2){pk2(h.x, h.y), pk2(h.z, h.w)}; asm volatile("global_store_dwordx2 %0, %1, off" : : "v"(o + 64 * j), "v"(hv) : "memory"); }
        { const unsigned h8 = pk4_fp8(h.x, h.y, h.z, h.w); asm volatile("global_store_dword %0, %1, off" : : "v"(o8 + 64 * j), "v"(h8) : "memory"); } }
}
__device__ __forceinline__ void p1_h1(Frame& F) {
    const int gw = F.bid * NWAVES + F.wave, NGW = F.G * NWAVES;
    const float* x = INF(0);
    for (int m = gw; m < NTOK; m += 2 * NGW) {
        const int m2 = m + NGW; const bool has2 = m2 < NTOK;
        f32x4 va[8], vb[8];
        { const f32x4* xa = (const f32x4*)(x + (size_t)m * DM) + F.lane; const f32x4* xb = (const f32x4*)(x + (size_t)(has2 ? m2 : m) * DM) + F.lane;
#pragma unroll
          for (int j = 0; j < 8; ++j) va[j] = xa[64 * j];
#pragma unroll
          for (int j = 0; j < 8; ++j) vb[j] = xb[64 * j]; }
        p1_row(F, va, m);
        if (has2) p1_row(F, vb, m2);
    }
}

struct GUnit { const bf16* A; const int* gl; int gcnt; const bf16* Bt; int orow, ocol, aux; };
struct GridSched {
    const bf16* A; const bf16* Bt; int lda, K, nM, nN, nwg, G, c;
    __device__ void init(const bf16* A_, int lda_, const bf16* Bt_, int K_, int M, int N, int G_, int c_) { A = A_; lda = lda_; Bt = Bt_; K = K_; nM = M / 256; nN = N / 256; nwg = nM * nN; G = G_; c = c_; }
    __device__ bool next(int i, GUnit& u) const {
        const long L = (long)i * G + c; if (L >= nwg) return false;
        int wgid = (int)L; { const int q = nwg / 8, r = nwg % 8, xcd = wgid % 8, off = wgid / 8; wgid = (xcd < r ? xcd * (q + 1) : r * (q + 1) + (xcd - r) * q) + off; }
        const int nig = 8 * nN, gid = wgid / nig, fm = gid * 8, gsz = (nM - fm) < 8 ? (nM - fm) : 8;
        const int pm = fm + ((wgid % nig) % gsz), pn = (wgid % nig) / gsz;
        u.A = A + (size_t)pm * 256 * lda; u.gl = nullptr; u.gcnt = 256; u.Bt = Bt + (size_t)pn * 256 * K; u.orow = pm * 256; u.ocol = pn * 256; u.aux = 0; return true;
    }
};

template <class Sched, class Epi>
__device__ __forceinline__ void gemm_naive(const Sched& S, const Epi& E) {
    GUnit u;
    for (int i = 0; S.next(i, u); ++i) {
        for (int it = threadIdx.x; it < 1024; it += NTHR) {
            const int r = it & 255, wc = it >> 8;
            const bf16* arow = u.gl ? u.A + (size_t)(r < u.gcnt ? u.gl[r] : 0) * S.lda : u.A + (size_t)r * S.lda;
            float part = 0.f;
#pragma unroll 1
            for (int fq = 0; fq < 4; ++fq) {
                const int c = 32 * wc + 8 * fq;
                float v0[8], v1[8];
#pragma unroll
                for (int j = 0; j < 8; ++j) { v0[j] = 0.f; v1[j] = 0.f; }
#pragma unroll 1
                for (int k = 0; k < S.K; k += 8) {
                    float a[8]; unpack8(*(const u32x4*)(arow + k), a);
#pragma unroll
                    for (int j = 0; j < 8; ++j) {
                        float b0[8], b1[8]; unpack8(*(const u32x4*)(u.Bt + (size_t)(c + j) * S.K + k), b0); unpack8(*(const u32x4*)(u.Bt + (size_t)(128 + c + j) * S.K + k), b1);
#pragma unroll
                        for (int q = 0; q < 8; ++q) { v0[j] += a[q] * b0[q]; v1[j] += a[q] * b1[q]; }
                    }
                }
#pragma unroll
                for (int j = 0; j < 8; ++j) part += v0[j] * v0[j] + v1[j] * v1[j];
                E.apply(u, r, c, v0, v1, E.begin(u, c));
            }
            if (Epi::ROWPART) E.rowpart(u, r, wc, part);
        }
    }
}

struct EpiG1 {
    static constexpr bool ROWPART = true, PREFETCH = false;
    struct St {}; __device__ __forceinline__ St begin(const GUnit&, int) const { return St{}; }
    bf16 *QL, *KVL, *U, *SGM, *SGS; float* RSS; int pn0;
    __device__ __forceinline__ void st(bf16* base, int ld, int row, int col, const float (&v)[8], bool sg) const {
        float f[8];
#pragma unroll
        for (int j = 0; j < 8; ++j) f[j] = sg ? sigm(v[j]) : v[j];
        *(u32x4*)(base + (size_t)row * ld + col) = pack8(f);
    }
    __device__ __forceinline__ void apply(const GUnit& u, int r, int c, const float (&v0)[8], const float (&v1)[8], const St&) const {
        const int pn = pn0 + (u.ocol >> 8), row = u.orow + r; bf16* base; int ld, col; bool sg = false;
        if (pn < 2) { base = QL; ld = QLORA; col = pn * 256; } else if (pn < 4) { base = KVL; ld = KVLORA; col = (pn - 2) * 256; } else if (pn < 8) { base = U; ld = S5CH; col = (pn - 4) * 256; }
        else if (pn < 16) { base = SGM; ld = DM; col = (pn - 8) * 256; sg = true; } else { base = SGS; ld = DM; col = (pn - 16) * 256; sg = true; }
        st(base, ld, row, col + c, v0, sg); st(base, ld, row, col + 128 + c, v1, sg);
    }
    __device__ __forceinline__ void rowpart(const GUnit& u, int r, int wc, float part) const {
        const int pn = pn0 + (u.ocol >> 8); if (pn < 4) RSS[(size_t)(pn >> 1) * NTOK * 8 + (size_t)(u.orow + r) * 8 + (pn & 1) * 4 + wc] = part;
    }
};
__device__ __forceinline__ float rs_from_parts(const float* p) { const f32x4 a = *(const f32x4*)p, b = *(const f32x4*)(p + 4); const float s = ((a.x + a.y) + (a.z + a.w)) + ((b.x + b.y) + (b.z + b.w)); return 1.0f / sqrtf(s * (1.0f / 512.0f) + EPS); }
struct P3Sched {
    const bf16 *QL, *KVL, *WUQ, *WUKV; int lda, K, G, c;
    __device__ bool next(int i, GUnit& u) const {
        int L = i * G + c; u.gl = nullptr; u.gcnt = 256;
        if (L < 192) { const int pm = L / 6, pn = L % 6; u.A = QL + (size_t)pm * 256 * 512; u.Bt = WUQ + (size_t)pn * 256 * 512; u.orow = pm * 256; u.ocol = pn * 256; u.aux = 0; return true; }
        L -= 192;
        if (L < 128) { const int pm = L / 4, pn = L % 4; u.A = KVL + (size_t)pm * 256 * 512; u.Bt = WUKV + (size_t)pn * 256 * 512; u.orow = pm * 256; u.ocol = pn * 256; u.aux = 1; return true; }
        L -= 128;
        if (L < 128) { const int pm = L % 4, pn = L / 4; u.A = WUKV + (size_t)(1024 + pm * 256) * 512; u.Bt = KVL + (size_t)pn * 256 * 512; u.orow = pm * 256; u.ocol = pn * 256; u.aux = 2; return true; }
        return false;
    }
};
struct EpiP3 {
    static constexpr bool ROWPART = false, PREFETCH = true; static constexpr int PFB = 2;
    bf16 *Q, *KN, *VT; const float* RSS; const f32x2* CS;
    struct St { float c0[8], c1[8]; };
    struct Ld { f32x4 p0, p1, t[2][2]; };
    __device__ __forceinline__ St begin(const GUnit& u, int c) const { St st;
#pragma unroll
        for (int j = 0; j < 8; ++j) { st.c0[j] = 0.f; st.c1[j] = 0.f; }
        if (u.aux == 2) {
#pragma unroll
            for (int j = 0; j < 8; ++j) { st.c0[j] = rs_from_parts(RSS + (size_t)NTOK * 8 + (size_t)(u.ocol + c + j) * 8); st.c1[j] = rs_from_parts(RSS + (size_t)NTOK * 8 + (size_t)(u.ocol + 128 + c + j) * 8); } }
        return st; }
    __device__ __forceinline__ int variant(const GUnit& u) const { return u.aux; }
    template <int V> __device__ __forceinline__ void load(const GUnit& u, int r, int c, const St&, Ld& L) const {
        const f32x4 z = (f32x4){0.f, 0.f, 0.f, 0.f}; L.p0 = z; L.p1 = z; L.t[0][0] = z; L.t[0][1] = z; L.t[1][0] = z; L.t[1][1] = z;
        if (V == 2) return;
        const float* p = RSS + (V == 1 ? (size_t)NTOK * 8 : (size_t)0) + (size_t)(u.orow + r) * 8; L.p0 = *(const f32x4*)p; L.p1 = *(const f32x4*)(p + 4);
        if (V == 0) {
#pragma unroll
            for (int h = 0; h < 2; ++h) { const int w = (u.ocol + c + 128 * h) % DQK;
                if (w >= DNOPE) { const f32x4* cs = (const f32x4*)(CS + (size_t)(u.orow + r) * 32 + 4 * ((w - DNOPE) >> 3)); L.t[h][0] = cs[0]; L.t[h][1] = cs[1]; } } }
    }
    template <int V> __device__ __forceinline__ void one(const GUnit& u, int r, int ct, const float (&v)[8], float rs, const float (&cs8)[8], const f32x4& t0, const f32x4& t1) const {
        const int row = u.orow + r, n = u.ocol + ct;
        if (V == 0) {
            const int h = n / DQK, w = n % DQK;
            if (w < DNOPE) { float f[8];
#pragma unroll
                for (int j = 0; j < 8; ++j) f[j] = v[j] * rs;
                *(u32x4*)(Q + (size_t)row * 1536 + n) = pack8(f); }
            else { const int a = (w - DNOPE) >> 3; const float tc[4] = {t0.x, t0.z, t1.x, t1.z}, ts[4] = {t0.y, t0.w, t1.y, t1.w}; float o1[4], o2[4];
#pragma unroll
                for (int j = 0; j < 4; ++j) { const float x1 = v[j] * rs, x2 = v[4 + j] * rs; o1[j] = x1 * tc[j] - x2 * ts[j]; o2[j] = x2 * tc[j] + x1 * ts[j]; }
                bf16* qp = Q + (size_t)row * 1536 + h * DQK + DNOPE + 4 * a;
                *(u32x2*)qp = (u32x2){pk2(o1[0], o1[1]), pk2(o1[2], o1[3])}; *(u32x2*)(qp + 32) = (u32x2){pk2(o2[0], o2[1]), pk2(o2[2], o2[3])}; }
        } else if (V == 1) {
            float f[8];
#pragma unroll
            for (int j = 0; j < 8; ++j) f[j] = v[j] * rs;
            *(u32x4*)(KN + (size_t)row * 1024 + n) = pack8(f);
        } else {
            float f[8];
#pragma unroll
            for (int j = 0; j < 8; ++j) f[j] = v[j] * cs8[j];
            *(u32x4*)(VT + (size_t)row * NTOK + n) = pack8(f);
        }
    }
    template <int V> __device__ __forceinline__ void apply(const GUnit& u, int r, int c, const float (&v0)[8], const float (&v1)[8], const St& st, const Ld& L) const {
        float rs = 0.f;
        if (V != 2) { const f32x4 a = L.p0, b = L.p1; const float s = ((a.x + a.y) + (a.z + a.w)) + ((b.x + b.y) + (b.z + b.w)); rs = 1.0f / sqrtf(s * (1.0f / 512.0f) + EPS); if (V == 0) rs *= QSCALE; }
        one<V>(u, r, c, v0, rs, st.c0, L.t[0][0], L.t[0][1]); one<V>(u, r, 128 + c, v1, rs, st.c1, L.t[1][0], L.t[1][1]); }
    __device__ __forceinline__ void apply(const GUnit& u, int r, int c, const float (&v0)[8], const float (&v1)[8], const St& st) const { Ld L;
        if (u.aux == 0) { load<0>(u, r, c, st, L); apply<0>(u, r, c, v0, v1, st, L); } else if (u.aux == 1) { load<1>(u, r, c, st, L); apply<1>(u, r, c, v0, v1, st, L); } else { load<2>(u, r, c, st, L); apply<2>(u, r, c, v0, v1, st, L); } }
    __device__ __forceinline__ void rowpart(const GUnit&, int, int, float) const {}
};
struct P5Sched {
    const bf16 *AO, *WBRM, *YG, *WGLU; int lda, K, G, c;
    __device__ bool next(int i, GUnit& u) const {
        int L = i * G + c; u.gl = nullptr; u.gcnt = 256;
        if (L < 128) { const int pm = L / 4, pn = L % 4; u.A = YG + (size_t)pm * 256 * 1024; u.Bt = WGLU + (size_t)pn * 256 * 1024; u.orow = pm * 256; u.ocol = pn * 256; u.aux = 1; return true; }
        L -= 128;
        if (L < 256) { const int pm = L / 8, pn = L % 8; u.A = AO + (size_t)pm * 256 * 1024; u.Bt = WBRM + (size_t)pn * 256 * 1024; u.orow = pm * 256; u.ocol = pn * 256; u.aux = 0; return true; }
        return false;
    }
};
struct EpiP5 {
    static constexpr bool ROWPART = false, PREFETCH = false;
    struct St {}; __device__ __forceinline__ St begin(const GUnit&, int) const { return St{}; }
    bf16 *M1, *S5O; const bf16 *SGM, *YG;
    __device__ __forceinline__ void one(const GUnit& u, int r, int ct, const float (&v)[8]) const {
        const int row = u.orow + r, n = u.ocol + ct; float g[8], f[8];
        if (u.aux == 0) { unpack8(*(const u32x4*)(SGM + (size_t)row * DM + n), g);
#pragma unroll
            for (int j = 0; j < 8; ++j) f[j] = g[j] * v[j];
            *(u32x4*)(M1 + (size_t)row * DM + n) = pack8(f); }
        else { unpack8(*(const u32x4*)(YG + (size_t)row * S5CH + n), g);
#pragma unroll
            for (int j = 0; j < 8; ++j) f[j] = g[j] * sigm(v[j]);
            *(u32x4*)(S5O + (size_t)row * S5CH + n) = pack8(f); }
    }
    __device__ __forceinline__ void apply(const GUnit& u, int r, int c, const float (&v0)[8], const float (&v1)[8], const St&) const { one(u, r, c, v0); one(u, r, 128 + c, v1); }
    __device__ __forceinline__ void rowpart(const GUnit&, int, int, float) const {}
};
struct GluSched {
    const bf16 *YG, *WGLU; int lda, K, G, c;
    __device__ __forceinline__ void a_ready(const GUnit&) const {}
    __device__ __forceinline__ void done(const GUnit&) const {}
    __device__ bool next(int i, GUnit& u) const {
        const int L = i * G + c; if (L >= 256) return false;
        const int ph = L >> 2, pn = L & 3; u.gl = nullptr; u.gcnt = 128; u.A = YG + (size_t)ph * 128 * 1024; u.Bt = WGLU + (size_t)pn * 256 * 1024; u.orow = ph * 128; u.ocol = pn * 256; u.aux = 1; return true;
    }
};
struct PairSched {
    const bf16 *AO, *WBRM, *S5O, *WBRS; int lda, K, G, c;
    __device__ __forceinline__ void a_ready(const GUnit&) const {}
    __device__ __forceinline__ void done(const GUnit&) const {}
    __device__ bool next(int i, GUnit& u) const {
        const int pair = (i >> 1) * G + c, which = i & 1; if (pair >= 256) return false;
        int wgid = pair; { const int q = 256 / 8, xcd = wgid % 8, off = wgid / 8; wgid = xcd * q + off; }
        const int nig = 8 * 8, gid = wgid / nig, fm = gid * 8; const int pm = fm + ((wgid % nig) % 8), pn = (wgid % nig) / 8;
        u.gl = nullptr; u.gcnt = 256; u.orow = pm * 256; u.ocol = pn * 256;
        if (which == 0) { u.A = AO + (size_t)pm * 256 * 1024; u.Bt = WBRM + (size_t)pn * 256 * 1024; u.aux = 0; }
        else { u.A = S5O + (size_t)pm * 256 * 1024; u.Bt = WBRS + (size_t)pn * 256 * 1024; u.aux = 2; }
        return true;
    }
};
struct EpiMix {
    static constexpr bool ROWPART = false, PREFETCH = true; static constexpr int PFB = 2;
    struct St {}; __device__ __forceinline__ St begin(const GUnit&, int) const { return St{}; }
    struct Ld { u32x4 g[2], m[2]; };
    bf16 *M1, *S5O; const bf16 *SGM, *SGS, *YG;
    __device__ __forceinline__ int variant(const GUnit& u) const { return u.aux; }
    template <int V> __device__ __forceinline__ void load(const GUnit& u, int r, int c, const St&, Ld& L) const {
        const int row = u.orow + r;
#pragma unroll
        for (int h = 0; h < 2; ++h) { const int n = u.ocol + c + 128 * h; L.g[h] = (u32x4){0u, 0u, 0u, 0u}; L.m[h] = (u32x4){0u, 0u, 0u, 0u};
            if (V == 0) L.g[h] = *(const u32x4*)(SGM + (size_t)row * DM + n);
            else if (V == 1) { if (r < u.gcnt) L.g[h] = *(const u32x4*)(YG + (size_t)row * S5CH + n); }
            else { L.g[h] = *(const u32x4*)(SGS + (size_t)row * DM + n); L.m[h] = *(const u32x4*)(M1 + (size_t)row * DM + n); } }
    }
    template <int V> __device__ __forceinline__ void one(const GUnit& u, int r, int ct, const float (&v)[8], const u32x4& gq, const u32x4& mq) const {
        const int row = u.orow + r, n = u.ocol + ct; float g[8], f[8]; unpack8(gq, g);
        if (V == 0) {
#pragma unroll
            for (int j = 0; j < 8; ++j) f[j] = g[j] * v[j];
            *(u32x4*)(M1 + (size_t)row * DM + n) = pack8(f); }
        else if (V == 1) { if (r >= u.gcnt) return;
#pragma unroll
            for (int j = 0; j < 8; ++j) f[j] = g[j] * sigm(v[j]);
            *(u32x4*)(S5O + (size_t)row * S5CH + n) = pack8(f); }
        else { float m[8]; unpack8(mq, m);
#pragma unroll
            for (int j = 0; j < 8; ++j) f[j] = m[j] + g[j] * v[j];
            *(u32x4*)(M1 + (size_t)row * DM + n) = pack8(f); }
    }
    template <int V> __device__ __forceinline__ void apply(const GUnit& u, int r, int c, const float (&v0)[8], const float (&v1)[8], const St&, const Ld& L) const { one<V>(u, r, c, v0, L.g[0], L.m[0]); one<V>(u, r, 128 + c, v1, L.g[1], L.m[1]); }
    __device__ __forceinline__ void apply(const GUnit& u, int r, int c, const float (&v0)[8], const float (&v1)[8], const St& st) const { Ld L;
        if (u.aux == 0) { load<0>(u, r, c, st, L); apply<0>(u, r, c, v0, v1, st, L); } else if (u.aux == 1) { load<1>(u, r, c, st, L); apply<1>(u, r, c, v0, v1, st, L); } else { load<2>(u, r, c, st, L); apply<2>(u, r, c, v0, v1, st, L); } }
    __device__ __forceinline__ void rowpart(const GUnit&, int, int, float) const {}
};
struct EpiP6 {
    static constexpr bool ROWPART = false, PREFETCH = false;
    struct St {}; __device__ __forceinline__ St begin(const GUnit&, int) const { return St{}; }
    bf16* M1; const bf16* SGS;
    __device__ __forceinline__ void one(const GUnit& u, int r, int ct, const float (&v)[8]) const {
        const int row = u.orow + r, n = u.ocol + ct; float g[8], m[8], f[8];
        unpack8(*(const u32x4*)(SGS + (size_t)row * DM + n), g); unpack8(*(const u32x4*)(M1 + (size_t)row * DM + n), m);
#pragma unroll
        for (int j = 0; j < 8; ++j) f[j] = m[j] + g[j] * v[j];
        *(u32x4*)(M1 + (size_t)row * DM + n) = pack8(f);
    }
    __device__ __forceinline__ void apply(const GUnit& u, int r, int c, const float (&v0)[8], const float (&v1)[8], const St&) const { one(u, r, c, v0); one(u, r, 128 + c, v1); }
    __device__ __forceinline__ void rowpart(const GUnit&, int, int, float) const {}
};
struct EpiBf16Plain {
    static constexpr bool ROWPART = false, PREFETCH = false;
    struct St {}; __device__ __forceinline__ St begin(const GUnit&, int) const { return St{}; }
    bf16* C; int ldc;
    __device__ __forceinline__ void apply(const GUnit& u, int r, int c, const float (&v0)[8], const float (&v1)[8], const St&) const {
        bf16* p = C + (size_t)(u.orow + r) * ldc + u.ocol + c; *(u32x4*)p = pack8(v0); *(u32x4*)(p + 128) = pack8(v1);
    }
    __device__ __forceinline__ void rowpart(const GUnit&, int, int, float) const {}
};
struct EpiF32 {
    static constexpr bool ROWPART = false, PREFETCH = false;
    struct St {}; __device__ __forceinline__ St begin(const GUnit&, int) const { return St{}; }
    float* C; int ldc;
    __device__ __forceinline__ void one(const GUnit& u, int r, int ct, const float (&v)[8]) const {
        float* p = C + (size_t)(u.orow + r) * ldc + u.ocol + ct; *(f32x4*)p = (f32x4){v[0], v[1], v[2], v[3]}; *(f32x4*)(p + 4) = (f32x4){v[4], v[5], v[6], v[7]};
    }
    __device__ __forceinline__ void apply(const GUnit& u, int r, int c, const float (&v0)[8], const float (&v1)[8], const St&) const { one(u, r, c, v0); one(u, r, 128 + c, v1); }
    __device__ __forceinline__ void rowpart(const GUnit&, int, int, float) const {}
};
struct MoeTab { LAS int* mtoff; LAS int* cnt; };
__device__ __forceinline__ void moe_build_tab(Frame& F, const MoeTab& T) {
    const unsigned* gc = WSP(unsigned, WS_CTL) + CW_CNT;
    if (F.tid < 64) { const int e = F.tid; const int c = (int)gc[e]; T.cnt[e] = c; int nt = (c + 255) >> 8, inc = nt;
#pragma unroll
        for (int o = 1; o < 64; o <<= 1) { const int t = __shfl_up(inc, o); if (e >= o) inc += t; }
        T.mtoff[e] = inc - nt; if (e == 63) { T.mtoff[64] = inc; T.mtoff[65] = inc + 32; } }
    __syncthreads();
}
__device__ __forceinline__ int moe_find_e(const MoeTab& T, int mt) { int e = 0;
#pragma unroll 1
    for (int s = 64; s >= 1; s >>= 1) { if (e + s <= 64 && T.mtoff[e + s] <= mt) e += s; }
    return e; }
template <int NPN, bool DOWN>
struct MoeSched {
    MoeTab T; const bf16* Ain; const bf16* AinS; const bf16* W; const int* rowtok; int lda, K, G, c;
    __device__ bool next(int i, GUnit& u) const {
        const int L = i * G + c; const int TM = T.mtoff[65]; if (L >= TM * NPN) return false;
        const int mt = L / NPN, pn = L % NPN; const int e = moe_find_e(T, mt); const int ml = mt - T.mtoff[e];
        u.aux = e; u.ocol = pn * 256; u.gl = nullptr; u.gcnt = 256;
        if (!DOWN) {
            u.Bt = W + (size_t)e * 1024 * K + (size_t)pn * 256 * K;
            if (e < NE) { u.A = Ain; u.gl = rowtok + (size_t)e * NTOK + ml * 256; u.gcnt = T.cnt[e] - ml * 256; u.orow = mt * 256; }
            else { u.A = Ain + (size_t)ml * 256 * K; u.orow = ml * 256; }
        } else {
            u.Bt = W + (size_t)e * DM * K + (size_t)pn * 256 * K;
            if (e < NE) { u.A = Ain + (size_t)mt * 256 * K; u.orow = mt * 256; u.gcnt = T.cnt[e] - ml * 256; } else { u.A = AinS + (size_t)ml * 256 * K; u.orow = ml * 256; }
        }
        return true;
    }
};
struct EpiGU {
    static constexpr bool ROWPART = false, PREFETCH = false;
    struct St {}; __device__ __forceinline__ St begin(const GUnit&, int) const { return St{}; }
    bf16 *ACT, *ACTS;
    __device__ __forceinline__ void apply(const GUnit& u, int r, int c, const float (&v0)[8], const float (&v1)[8], const St&) const {
        float f[8];
#pragma unroll
        for (int j = 0; j < 8; ++j) f[j] = v0[j] * sigm(v0[j]) * v1[j];
        if (r >= u.gcnt) return;
        unsigned char* base = (unsigned char*)((u.aux < NE) ? ACT : ACTS);
        *(u32x2*)(base + (size_t)(u.orow + r) * DE + (u.ocol >> 1) + c) = (u32x2){pk4_fp8(f[0] * ACT_SCALE, f[1] * ACT_SCALE, f[2] * ACT_SCALE, f[3] * ACT_SCALE), pk4_fp8(f[4] * ACT_SCALE, f[5] * ACT_SCALE, f[6] * ACT_SCALE, f[7] * ACT_SCALE)};
    }
    __device__ __forceinline__ void rowpart(const GUnit&, int, int, float) const {}
};
struct EpiDown {
    static constexpr bool ROWPART = false, PREFETCH = false;
    struct St {}; __device__ __forceinline__ St begin(const GUnit&, int) const { return St{}; }
    bf16 *Y, *YS;
    __device__ __forceinline__ void apply(const GUnit& u, int r, int c, const float (&v0)[8], const float (&v1)[8], const St&) const {
        if (r >= u.gcnt) return;
        unsigned char* p = (unsigned char*)((u.aux < NE) ? Y : YS) + (size_t)(u.orow + r) * DM + u.ocol + c;
        *(u32x2*)p = (u32x2){pk4_fp8(v0[0] * Y_SCALE, v0[1] * Y_SCALE, v0[2] * Y_SCALE, v0[3] * Y_SCALE), pk4_fp8(v0[4] * Y_SCALE, v0[5] * Y_SCALE, v0[6] * Y_SCALE, v0[7] * Y_SCALE)};
        *(u32x2*)(p + 128) = (u32x2){pk4_fp8(v1[0] * Y_SCALE, v1[1] * Y_SCALE, v1[2] * Y_SCALE, v1[3] * Y_SCALE), pk4_fp8(v1[4] * Y_SCALE, v1[5] * Y_SCALE, v1[6] * Y_SCALE, v1[7] * Y_SCALE)};
    }
    __device__ __forceinline__ void rowpart(const GUnit&, int, int, float) const {}
};

namespace pg8 {
typedef int v4i32 __attribute__((ext_vector_type(4)));
typedef int v8i32 __attribute__((ext_vector_type(8)));
constexpr int BM = 256, BK = 64, HALF = 128, HTB = HALF * BK * 2, STAGE_BYTES = 8 * HTB;
__device__ __forceinline__ int lds_byte(int r, int c) { const int st = (r >> 4) * 2 + (c >> 5), rr = r & 15, cc = c & 31, ob = rr * 64 + cc * 2; return st * 1024 + (ob ^ (((ob >> 9) & 1) << 5)); }
__device__ __forceinline__ void stage_rc(int b, int& R, int& C) { const int st = b / 1024, sb = b % 1024, swz = sb ^ (((sb >> 9) & 1) << 5); R = (st >> 1) * 16 + swz / 64; C = (st & 1) * 32 + (swz % 64) / 2; }
__device__ __forceinline__ int perm32(int rho) { const int n = rho >> 4, i = rho & 15; return 8 * (i >> 2) + 4 * n + (i & 3); }

template <class Epi, int V>
__device__ __forceinline__ void run_epi_pf(const Epi& E, const GUnit& u, const f32x4 (&acc)[2][2][4][2], int wr, int wc, int fr, int fq, const typename Epi::St& st) {
    constexpr int PFB = Epi::PFB; const int c = wc * 32 + 8 * fq;
#pragma unroll
    for (int b0 = 0; b0 < 8; b0 += PFB) {
        typename Epi::Ld ld[PFB];
#pragma unroll
        for (int q = 0; q < PFB; ++q) { const int ai = (b0 + q) >> 2, m = (b0 + q) & 3; E.template load<V>(u, ai * HALF + wr * 64 + m * 16 + fr, c, st, ld[q]); }
#pragma unroll
        for (int q = 0; q < PFB; ++q) { const int ai = (b0 + q) >> 2, m = (b0 + q) & 3; const int r = ai * HALF + wr * 64 + m * 16 + fr;
            float v0[8], v1[8];
#pragma unroll
            for (int j = 0; j < 4; ++j) { v0[j] = acc[ai][0][m][0][j]; v0[4 + j] = acc[ai][0][m][1][j]; v1[j] = acc[ai][1][m][0][j]; v1[4 + j] = acc[ai][1][m][1][j]; }
            E.template apply<V>(u, r, c, v0, v1, st, ld[q]); }
    }
}
template <class Epi>
__device__ __forceinline__ void run_epi(const Epi& E, const GUnit& u, const f32x4 (&acc)[2][2][4][2], int wr, int wc, int fr, int fq) {
    const typename Epi::St st = E.begin(u, wc * 32 + 8 * fq);
    if constexpr (Epi::PREFETCH) {
        const int var = E.variant(u);
        if (var == 0) run_epi_pf<Epi, 0>(E, u, acc, wr, wc, fr, fq, st); else if (var == 1) run_epi_pf<Epi, 1>(E, u, acc, wr, wc, fr, fq, st); else run_epi_pf<Epi, 2>(E, u, acc, wr, wc, fr, fq, st);
    } else {
#pragma unroll
    for (int ai = 0; ai < 2; ++ai)
#pragma unroll
        for (int m = 0; m < 4; ++m) {
            const int r = ai * HALF + wr * 64 + m * 16 + fr, c = wc * 32 + 8 * fq;
            float v0[8], v1[8];
#pragma unroll
            for (int j = 0; j < 4; ++j) { v0[j] = acc[ai][0][m][0][j]; v0[4 + j] = acc[ai][0][m][1][j]; v1[j] = acc[ai][1][m][0][j]; v1[4 + j] = acc[ai][1][m][1][j]; }
            E.apply(u, r, c, v0, v1, st);
            if (Epi::ROWPART) { float part = 0.f;
#pragma unroll
                for (int j = 0; j < 8; ++j) part += v0[j] * v0[j] + v1[j] * v1[j];
                part += __shfl_xor(part, 16); part += __shfl_xor(part, 32);
                if (fq == 0) E.rowpart(u, r, wc, part); }
        }
    }
}

template <class Sched, class Epi, bool GATHER, bool HALFSKIP, int FP8W = 0, int FP8A = 0>
__device__ __forceinline__ void gemm_phase(LAS unsigned char* lds, const Sched& S, const Epi& E) {
    const int tid = threadIdx.x, wid = __builtin_amdgcn_readfirstlane(tid >> 6), lane = tid & 63, wr = wid >> 2, wc = wid & 3, fr = lane & 15, fq = lane >> 4;
    const int K = S.K, nt = K / BK, lda = S.lda;
    int RA[2], CA[2]; unsigned voffB[2];
#pragma unroll
    for (int i = 0; i < 2; ++i) { int R, C; stage_rc(tid * 16 + i * 8192, R, C); RA[i] = R; CA[i] = C; const int Rb = (R & ~31) + perm32(R & 31); voffB[i] = (unsigned)(Rb * K + C) * 2u; }
    const size_t kstep = (size_t)(BK * 2);
    const size_t hstepB = (size_t)HALF * K * 2;
    const unsigned ldsw = (unsigned)wid * 1024u;
    const int aoff = lds_byte(wr * 64 + fr, fq * 8), boff = lds_byte(wc * 32 + fr, fq * 8);
#define PG8_SA(b, h) (((b) * 2 + (h)) * HTB)
#define PG8_SB(b, h) ((4 + (b) * 2 + (h)) * HTB)
#define PG8_STAGE(bufoff, gbase, v0_, v1_) do { \
        __builtin_amdgcn_global_load_lds((const unsigned*)((const char*)(gbase) + (v0_)), (LAS unsigned*)(lds + (bufoff) + ldsw), 16, 0, 0); \
        __builtin_amdgcn_global_load_lds((const unsigned*)((const char*)(gbase) + (v1_)), (LAS unsigned*)(lds + (bufoff) + ldsw + 8192), 16, 0, 0); } while (0)
#define PG8_STAGEB(bufoff, gbase) PG8_STAGE(bufoff, gbase, voffB[0], voffB[1])
#define PG8_LDA(dst, b, h) do { if constexpr (FP8W != 0) { _Pragma("unroll") for (int m = 0; m < 4; ++m) { const v4i32 lo_ = *(const LAS v4i32*)(lds + PG8_SA(b, h) + aoff + m * 2048), hi_ = *(const LAS v4i32*)(lds + PG8_SA(b, h) + aoff + m * 2048 + 1024); \
            dst##8[m] = __builtin_shufflevector(lo_, hi_, 0, 1, 2, 3, 4, 5, 6, 7); } } \
        else { _Pragma("unroll") for (int m = 0; m < 4; ++m) _Pragma("unroll") for (int k = 0; k < 2; ++k) dst[m][k] = *(const LAS bf16x8*)(lds + PG8_SA(b, h) + aoff + m * 2048 + k * 1024); } } while (0)
#define PG8_LDB(dst, b, h) do { if constexpr (FP8W != 0) { _Pragma("unroll") for (int n = 0; n < 2; ++n) { const v4i32 lo_ = *(const LAS v4i32*)(lds + PG8_SB(b, h) + boff + n * 2048), hi_ = *(const LAS v4i32*)(lds + PG8_SB(b, h) + boff + n * 2048 + 1024); \
            dst##8[n] = __builtin_shufflevector(lo_, hi_, 0, 1, 2, 3, 4, 5, 6, 7); } } \
        else { _Pragma("unroll") for (int n = 0; n < 2; ++n) _Pragma("unroll") for (int k = 0; k < 2; ++k) dst[n][k] = *(const LAS bf16x8*)(lds + PG8_SB(b, h) + boff + n * 2048 + k * 1024); } } while (0)
#define PG8_MMA(ai, bj, At, Bt) do { __builtin_amdgcn_s_setprio(1); \
        if constexpr (FP8W != 0) { _Pragma("unroll") for (int m = 0; m < 4; ++m) _Pragma("unroll") for (int n = 0; n < 2; ++n) \
            asm volatile("v_mfma_scale_f32_16x16x128_f8f6f4 %0, %1, %2, %0, %3, %4 op_sel_hi:[0,0,0]" : "+v"(acc[ai][bj][m][n]) : "v"(Bt##8[n]), "v"(At##8[m]), "v"(sclW), "v"(sclA)); } \
        else { _Pragma("unroll") for (int m = 0; m < 4; ++m) _Pragma("unroll") for (int n = 0; n < 2; ++n) _Pragma("unroll") for (int k = 0; k < 2; ++k) \
            acc[ai][bj][m][n] = __builtin_amdgcn_mfma_f32_16x16x32_bf16(Bt[n][k], At[m][k], acc[ai][bj][m][n], 0, 0, 0); } \
        __builtin_amdgcn_s_setprio(0); } while (0)
#define PG8_WAIT_V(n) asm volatile("s_waitcnt vmcnt(" #n ")" ::: "memory")
#define PG8_WAIT_L(n) asm volatile("s_waitcnt lgkmcnt(" #n ")" ::: "memory")
#define PG8_BAR __builtin_amdgcn_s_barrier()
#define PG8_SCHED __builtin_amdgcn_sched_barrier(0)
#define PG8_VOFF(u, dst) do { _Pragma("unroll") for (int h = 0; h < 2; ++h) _Pragma("unroll") for (int i = 0; i < 2; ++i) { const int row = h * HALF + RA[i]; \
        if (GATHER && (u).gl) { const int tok = (row < (u).gcnt) ? (u).gl[row] : 0; dst[h][i] = (unsigned)(tok * lda + CA[i]) * 2u; } \
        else dst[h][i] = (unsigned)(row * lda + CA[i]) * 2u; } } while (0)
    GUnit cur, nxt; int ui = 0;
    if (!S.next(0, cur)) return;
    f32x4 acc[2][2][4][2];
#pragma unroll
    for (int a = 0; a < 2; ++a)
#pragma unroll
        for (int b = 0; b < 2; ++b)
#pragma unroll
            for (int m = 0; m < 4; ++m)
#pragma unroll
                for (int n = 0; n < 2; ++n) acc[a][b][m][n] = (f32x4){0.f, 0.f, 0.f, 0.f};
    bf16x8 At[4][2], B0[2][2], B1[2][2]; v8i32 At8[4], B08[2], B18[2];
    const int sclW = FP8W * 0x01010101, sclA = FP8A * 0x01010101;
    unsigned vA[2][2], vN[2][2];
    PG8_VOFF(cur, vA);
    const char* cA = (const char*)cur.A; const char* cB = (const char*)cur.Bt;
    PG8_STAGEB(PG8_SB(0, 0), cB); PG8_STAGEB(PG8_SB(0, 1), cB + hstepB); PG8_STAGE(PG8_SA(0, 0), cA, vA[0][0], vA[0][1]); PG8_STAGE(PG8_SA(0, 1), cA, vA[1][0], vA[1][1]);
    if (wr == 1) PG8_BAR;
    PG8_WAIT_V(2); PG8_BAR;
    PG8_STAGEB(PG8_SB(1, 0), cB + kstep); PG8_STAGE(PG8_SA(1, 0), cA + kstep, vA[0][0], vA[0][1]); PG8_STAGEB(PG8_SB(1, 1), cB + hstepB + kstep);
    PG8_WAIT_V(6); PG8_BAR;
    for (;;) {
        const bool has_next = S.next(ui + 1, nxt);
        if (has_next) { PG8_VOFF(nxt, vN); } else {
#pragma unroll
            for (int h = 0; h < 2; ++h)
#pragma unroll
                for (int i = 0; i < 2; ++i) vN[h][i] = vA[h][i]; }
        const char* nA = has_next ? (const char*)nxt.A : cA; const char* nB = has_next ? (const char*)nxt.Bt : cB;
        const bool full = !HALFSKIP || cur.gcnt > HALF;
        for (int t = 0; t < nt; t += 2) {
            const bool last = (t == nt - 2);
            const char* a1 = cA + (size_t)(t + 1) * kstep;
            const char* a2 = last ? nA : cA + (size_t)(t + 2) * kstep; const char* b2 = last ? nB : cB + (size_t)(t + 2) * kstep;
            const char* a3 = a2 + kstep; const char* b3 = b2 + kstep;
            const unsigned w00 = last ? vN[0][0] : vA[0][0], w01 = last ? vN[0][1] : vA[0][1], w10 = last ? vN[1][0] : vA[1][0], w11 = last ? vN[1][1] : vA[1][1];
            PG8_LDB(B0, 0, 0); PG8_LDB(B1, 0, 1); PG8_SCHED; PG8_LDA(At, 0, 0); PG8_STAGE(PG8_SA(1, 1), a1, vA[1][0], vA[1][1]);
            PG8_WAIT_V(8); PG8_WAIT_L(0); PG8_BAR; PG8_MMA(0, 0, At, B0); PG8_MMA(0, 1, At, B1); PG8_BAR; PG8_SCHED;
            if (full) { PG8_LDA(At, 0, 1); } PG8_STAGEB(PG8_SB(0, 0), b2); PG8_STAGEB(PG8_SB(0, 1), b2 + hstepB); PG8_STAGE(PG8_SA(0, 0), a2, w00, w01);
            PG8_WAIT_V(8); PG8_WAIT_L(0); PG8_BAR; if (full) { PG8_MMA(1, 0, At, B0); PG8_MMA(1, 1, At, B1); } PG8_BAR; PG8_SCHED;
            PG8_LDB(B0, 1, 0); PG8_LDB(B1, 1, 1); PG8_SCHED; PG8_LDA(At, 1, 0); PG8_STAGE(PG8_SA(0, 1), a2, w10, w11);
            PG8_WAIT_V(8); PG8_WAIT_L(0); PG8_BAR; PG8_MMA(0, 0, At, B0); PG8_MMA(0, 1, At, B1); PG8_BAR; PG8_SCHED;
            if (full) { PG8_LDA(At, 1, 1); } PG8_STAGEB(PG8_SB(1, 0), b3); PG8_STAGEB(PG8_SB(1, 1), b3 + hstepB); PG8_STAGE(PG8_SA(1, 0), a3, w00, w01);
            PG8_WAIT_V(8); PG8_WAIT_L(0); PG8_BAR; if (full) { PG8_MMA(1, 0, At, B0); PG8_MMA(1, 1, At, B1); } PG8_BAR; PG8_SCHED;
        }
        if (wr == 0) PG8_BAR;
        if constexpr (FP8W != 0) asm volatile("s_nop 15\n\ts_nop 15" ::: "memory");
        run_epi(E, cur, acc, wr, wc, fr, fq);
        if (!has_next) break;
#pragma unroll
        for (int a = 0; a < 2; ++a)
#pragma unroll
            for (int b = 0; b < 2; ++b)
#pragma unroll
                for (int m = 0; m < 4; ++m)
#pragma unroll
                    for (int n = 0; n < 2; ++n) acc[a][b][m][n] = (f32x4){0.f, 0.f, 0.f, 0.f};
        cur = nxt; cA = nA; cB = nB; ++ui;
#pragma unroll
        for (int h = 0; h < 2; ++h)
#pragma unroll
            for (int i = 0; i < 2; ++i) vA[h][i] = vN[h][i];
        if (wr == 1) PG8_BAR;
    }
    PG8_WAIT_V(0);
    PG8_BAR;
#undef PG8_SA
#undef PG8_SB
#undef PG8_STAGE
#undef PG8_STAGEB
#undef PG8_LDA
#undef PG8_LDB
#undef PG8_MMA
#undef PG8_WAIT_V
#undef PG8_WAIT_L
#undef PG8_BAR
#undef PG8_SCHED
#undef PG8_VOFF
}
}
#ifndef OPT_GEMM
#define OPT_GEMM 1
#endif
template <bool GATHER, bool HALFSKIP = false, int FP8W = 0, int FP8A = 0, class Sched, class Epi>
__device__ __forceinline__ void gemm_run(Frame& F, const Sched& S, const Epi& E) {
#if OPT_GEMM
    pg8::gemm_phase<Sched, Epi, GATHER, HALFSKIP, FP8W, FP8A>(F.lds, S, E);
#else
    gemm_naive(S, E);
#endif
}

struct ThinArgs { const bf16* A[3]; const bf16* B[3]; };
template <int NSEG>
__device__ __forceinline__ void thin_dot8(const ThinArgs& t, int row, int c8, float (&acc)[8]) {
#pragma unroll
    for (int j = 0; j < 8; ++j) acc[j] = 0.f;
#pragma unroll
    for (int s = 0; s < NSEG; ++s) { const bf16* a = t.A[s] + (size_t)row * DM; const bf16* b = t.B[s] + (size_t)c8 * DM;
#pragma unroll 1
        for (int k = 0; k < DM; k += 8) { float av[8]; unpack8(*(const u32x4*)(a + k), av);
#pragma unroll
            for (int j = 0; j < 8; ++j) { float bv[8]; unpack8(*(const u32x4*)(b + (size_t)j * DM + k), bv);
#pragma unroll
                for (int q = 0; q < 8; ++q) acc[j] += av[q] * bv[q]; } } }
}
__device__ __forceinline__ void p3_kpe_naive(Frame& F) {
    ThinArgs t; t.A[0] = WSP(bf16, WS_H); t.B[0] = WSP(bf16, WS_WPE); t.A[1] = t.A[2] = t.A[0]; t.B[1] = t.B[2] = t.B[0];
    const f32x2* CS = WSP(f32x2, WS_ROPE); bf16* KPE = WSP(bf16, WS_KPE);
    for (int it = F.bid * NTHR + F.tid; it < NTOK * 4; it += F.G * NTHR) {
        const int row = it >> 2, c8 = (it & 3) * 8; float x1[8], x2[8];
        thin_dot8<1>(t, row, c8, x1); thin_dot8<1>(t, row, 32 + c8, x2);
        float o1[8], o2[8];
#pragma unroll
        for (int j = 0; j < 8; ++j) { const f32x2 cs = CS[(size_t)row * 32 + c8 + j]; o1[j] = x1[j] * cs.x - x2[j] * cs.y; o2[j] = x2[j] * cs.x + x1[j] * cs.y; }
        *(u32x4*)(KPE + (size_t)row * 64 + c8) = pack8(o1); *(u32x4*)(KPE + (size_t)row * 64 + 32 + c8) = pack8(o2);
    }
}

typedef float f32x4v __attribute__((ext_vector_type(4)));
template <bool ROUTER>
__device__ __forceinline__ void thin_mfma_partials(Frame& F, const bf16* A0, const bf16* A1, const bf16* B0, const bf16* B1, int m0, LAS float* red) {
    const int ru = F.wave & 1, kq4 = F.wave >> 1, r16 = F.lane & 15, kq = F.lane >> 4;
    f32x4 acc[4];
#pragma unroll
    for (int cb = 0; cb < 4; ++cb) acc[cb] = (f32x4){0.f, 0.f, 0.f, 0.f};
    const size_t aoff = (size_t)(m0 + 16 * ru + r16) * DM + 512 * kq4 + 8 * kq, boff = (size_t)r16 * DM + 512 * kq4 + 8 * kq;
#pragma unroll 8
    for (int ks = 0; ks < 16; ++ks) {
        const bf16x8 ah = *(const bf16x8*)(A0 + aoff + 32 * ks);
        bf16x8 al; if (ROUTER) al = *(const bf16x8*)(A1 + aoff + 32 * ks);
#pragma unroll
        for (int cb = 0; cb < 4; ++cb) {
            const bf16x8 bh = *(const bf16x8*)(B0 + boff + (size_t)cb * 16 * DM + 32 * ks);
            acc[cb] = __builtin_amdgcn_mfma_f32_16x16x32_bf16(ah, bh, acc[cb], 0, 0, 0);
            if (ROUTER) { const bf16x8 bl = *(const bf16x8*)(B1 + boff + (size_t)cb * 16 * DM + 32 * ks);
                acc[cb] = __builtin_amdgcn_mfma_f32_16x16x32_bf16(al, bh, acc[cb], 0, 0, 0);
                acc[cb] = __builtin_amdgcn_mfma_f32_16x16x32_bf16(ah, bl, acc[cb], 0, 0, 0); }
        }
    }
#pragma unroll
    for (int cb = 0; cb < 4; ++cb)
#pragma unroll
        for (int rg = 0; rg < 4; ++rg) red[(F.wave * 16 + 4 * kq + rg) * 64 + cb * 16 + r16] = acc[cb][rg];
}
__device__ __forceinline__ f32x4 thin_reduce4(const LAS float* red, int row32, int c4) {
    const int ru = row32 >> 4, r = row32 & 15; f32x4 s = (f32x4){0.f, 0.f, 0.f, 0.f};
#pragma unroll
    for (int q = 0; q < 4; ++q) s += *(const LAS f32x4*)(red + ((q * 2 + ru) * 16 + r) * 64 + c4);
    return s;
}
__device__ __forceinline__ void p3_kpe_mfma(Frame& F) {
    LAS float* red = (LAS float*)F.lds; const f32x2* CS = WSP(f32x2, WS_ROPE); bf16* KPE = WSP(bf16, WS_KPE);
    for (int blk = F.bid; blk < NTOK / 32; blk += F.G) {
        const int m0 = blk * 32;
        thin_mfma_partials<false>(F, WSP(bf16, WS_H), nullptr, WSP(bf16, WS_WPE), nullptr, m0, red);
        __syncthreads();
        if (F.tid < 256) { const int row32 = F.tid >> 3, c4 = (F.tid & 7) * 4, row = m0 + row32;
            const f32x4 x1 = thin_reduce4(red, row32, c4), x2 = thin_reduce4(red, row32, 32 + c4); float o1[4], o2[4];
#pragma unroll
            for (int j = 0; j < 4; ++j) { const f32x2 cs = CS[(size_t)row * 32 + c4 + j]; o1[j] = x1[j] * cs.x - x2[j] * cs.y; o2[j] = x2[j] * cs.x + x1[j] * cs.y; }
            *(u32x2*)(KPE + (size_t)row * 64 + c4) = (u32x2){pk2(o1[0], o1[1]), pk2(o1[2], o1[3])}; *(u32x2*)(KPE + (size_t)row * 64 + 32 + c4) = (u32x2){pk2(o2[0], o2[1]), pk2(o2[2], o2[3])}; }
        __syncthreads();
    }
}
#ifndef OPT_THIN
#define OPT_THIN 1
#endif

__device__ __forceinline__ void s5_pass1(Frame& F) {
    const bf16* U = WSP(bf16, WS_U); const f32x2* abar = WSP(f32x2, WS_S5P); const f32x2* bbar = abar + 8192; f32x2* E = WSP(f32x2, WS_S5E);
    LAS float* us = (LAS float*)(F.lds + F.wave * 4096);
    const int gw = F.bid * NWAVES + F.wave, NGW = F.G * NWAVES;
    for (int un = gw; un < NB * NCHUNK * S5G; un += NGW) {
        const int g = un % S5G, ch = (un / S5G) % NCHUNK, b = un / (S5G * NCHUNK); const int t0 = b * SEQ + ch * SCH;
        { const int t = F.lane; float f[8], f2[8]; unpack8(*(const u32x4*)(U + (size_t)(t0 + t) * S5CH + g * 16), f); unpack8(*(const u32x4*)(U + (size_t)(t0 + t) * S5CH + g * 16 + 8), f2);
#pragma unroll
          for (int j = 0; j < 8; ++j) { us[t * 16 + j] = f[j]; us[t * 16 + 8 + j] = f2[j]; } }
        LDS_WAIT();
        const int p = F.lane; const f32x2 a = abar[g * 64 + p]; float br[16], bi[16];
#pragma unroll
        for (int c = 0; c < 16; ++c) { const f32x2 t = bbar[(size_t)(g * 64 + p) * 16 + c]; br[c] = t.x; bi[c] = t.y; }
        float xr = 0.f, xi = 0.f;
#pragma unroll 1
        for (int t = 0; t < SCH; ++t) { float ur = 0.f, ui = 0.f;
#pragma unroll
            for (int c4 = 0; c4 < 4; ++c4) { const f32x4 uv = *(LAS f32x4*)(us + t * 16 + 4 * c4);
                ur += uv.x * br[4 * c4] + uv.y * br[4 * c4 + 1] + uv.z * br[4 * c4 + 2] + uv.w * br[4 * c4 + 3]; ui += uv.x * bi[4 * c4] + uv.y * bi[4 * c4 + 1] + uv.z * bi[4 * c4 + 2] + uv.w * bi[4 * c4 + 3]; }
            const float nr = a.x * xr - a.y * xi + ur, ni = a.x * xi + a.y * xr + ui; xr = nr; xi = ni; }
        E[((size_t)(b * NCHUNK + ch) * S5G + g) * 64 + p] = (f32x2){xr, xi};
        LDS_WAIT();
    }
}
__device__ __forceinline__ float gelu_tanh(float x) { const float u = 0.7978845608028654f * (x + 0.044715f * x * x * x); const float e = __expf(2.0f * u); const float th = 1.0f - 2.0f / (e + 1.0f); return 0.5f * x * (1.0f + th); }
__device__ __forceinline__ void s5_pass2(Frame& F) {
    const bf16* U = WSP(bf16, WS_U); const f32x2* abar = WSP(f32x2, WS_S5P); const f32x2* apow = abar + 4096; const f32x2* bbar = abar + 8192; const f32x2* E = WSP(f32x2, WS_S5E);
    const float* cre = INF(20); const float* cim = INF(21); const float* dsk = INF(22); bf16* YG = WSP(bf16, WS_YG);
    LAS float* us = (LAS float*)(F.lds + F.wave * 16384);
    LAS float* xs = us + 1024;
    const int gw = F.bid * NWAVES + F.wave, NGW = F.G * NWAVES;
    for (int un = gw; un < NB * NCHUNK * S5G; un += NGW) {
        const int g = un % S5G, ch = (un / S5G) % NCHUNK, b = un / (S5G * NCHUNK); const int t0 = b * SEQ + ch * SCH;
        { const int t = F.lane; float f[8], f2[8]; unpack8(*(const u32x4*)(U + (size_t)(t0 + t) * S5CH + g * 16), f); unpack8(*(const u32x4*)(U + (size_t)(t0 + t) * S5CH + g * 16 + 8), f2);
#pragma unroll
          for (int j = 0; j < 8; ++j) { us[t * 16 + j] = f[j]; us[t * 16 + 8 + j] = f2[j]; } }
        LDS_WAIT();
        const int p = F.lane; const f32x2 a = abar[g * 64 + p], aw = apow[g * 64 + p]; float br[16], bi[16];
#pragma unroll
        for (int c = 0; c < 16; ++c) { const f32x2 t = bbar[(size_t)(g * 64 + p) * 16 + c]; br[c] = t.x; bi[c] = t.y; }
        float xr = 0.f, xi = 0.f;
#pragma unroll 1
        for (int j = 0; j < ch; ++j) { const f32x2 e = E[((size_t)(b * NCHUNK + j) * S5G + g) * 64 + p]; const float nr = aw.x * xr - aw.y * xi + e.x, ni = aw.x * xi + aw.y * xr + e.y; xr = nr; xi = ni; }
        const int tt = F.lane >> 2, c4 = F.lane & 3;
#pragma unroll 1
        for (int sb = 0; sb < SCH / 16; ++sb) {
#pragma unroll 1
            for (int t = 0; t < 16; ++t) { const int tg = sb * 16 + t; float ur = 0.f, ui = 0.f;
#pragma unroll
                for (int q = 0; q < 4; ++q) { const f32x4 uv = *(LAS f32x4*)(us + tg * 16 + 4 * q);
                    ur += uv.x * br[4 * q] + uv.y * br[4 * q + 1] + uv.z * br[4 * q + 2] + uv.w * br[4 * q + 3]; ui += uv.x * bi[4 * q] + uv.y * bi[4 * q + 1] + uv.z * bi[4 * q + 2] + uv.w * bi[4 * q + 3]; }
                const float nr = a.x * xr - a.y * xi + ur, ni = a.x * xi + a.y * xr + ui; xr = nr; xi = ni;
                *(LAS f32x2*)(xs + (t * 64 + p) * 2) = (f32x2){xr, xi}; }
            LDS_WAIT();
            float y[4] = {0.f, 0.f, 0.f, 0.f};
#pragma unroll 1
            for (int q = 0; q < 64; ++q) { const f32x2 x = *(LAS f32x2*)(xs + (tt * 64 + q) * 2);
#pragma unroll
                for (int j = 0; j < 4; ++j) { const size_t ci = (size_t)(g * 16 + 4 * c4 + j) * 64 + q; y[j] += x.x * cre[ci] - x.y * cim[ci]; } }
            const int tg = sb * 16 + tt; float o[4];
#pragma unroll
            for (int j = 0; j < 4; ++j) { const int c = 4 * c4 + j; o[j] = gelu_tanh(y[j] + dsk[g * 16 + c] * us[tg * 16 + c]); }
            *(u32x2*)(YG + (size_t)(t0 + tg) * S5CH + g * 16 + 4 * c4) = (u32x2){pk2(o[0], o[1]), pk2(o[2], o[3])};
            LDS_WAIT();
        }
    }
}

__device__ __forceinline__ void s5_pass2_mfma(Frame& F) {
    const bf16* U = WSP(bf16, WS_U); const f32x2* abar = WSP(f32x2, WS_S5P); const f32x2* apow = abar + 4096; const f32x2* bbar = abar + 8192; const f32x2* E = WSP(f32x2, WS_S5E);
    const float* cre = INF(20); const float* cim = INF(21); const float* dsk = INF(22); bf16* YG = WSP(bf16, WS_YG);
    LAS float* us = (LAS float*)(F.lds + F.wave * 8704);
    LAS unsigned char* xs = (LAS unsigned char*)us + 4096;
    const int gw = F.bid * NWAVES + F.wave, NGW = F.G * NWAVES;
    const int c16 = F.lane & 15, kq = F.lane >> 4;
    for (int un = gw; un < NB * NCHUNK * S5G; un += NGW) {
        const int g = un % S5G, ch = (un / S5G) % NCHUNK, b = un / (S5G * NCHUNK); const int t0 = b * SEQ + ch * SCH;
        { const int t = F.lane; float f[8], f2[8]; unpack8(*(const u32x4*)(U + (size_t)(t0 + t) * S5CH + g * 16), f); unpack8(*(const u32x4*)(U + (size_t)(t0 + t) * S5CH + g * 16 + 8), f2);
#pragma unroll
          for (int j = 0; j < 8; ++j) { us[t * 16 + j] = f[j]; us[t * 16 + 8 + j] = f2[j]; } }
        const int p = F.lane; const f32x2 a = abar[g * 64 + p], aw = apow[g * 64 + p]; float br[16], bi[16];
#pragma unroll
        for (int c = 0; c < 16; ++c) { const f32x2 t = bbar[(size_t)(g * 64 + p) * 16 + c]; br[c] = t.x; bi[c] = t.y; }
        bf16x8 cf[4];
#pragma unroll
        for (int ks = 0; ks < 4; ++ks) { const int k0 = 32 * ks + 8 * kq; const float* src = (ks < 2) ? cre + (size_t)(g * 16 + c16) * 64 + k0 : cim + (size_t)(g * 16 + c16) * 64 + (k0 - 64);
            const f32x4 v0 = *(const f32x4*)src, v1 = *(const f32x4*)(src + 4); const float sg = (ks < 2) ? 1.f : -1.f;
            u32x4 w; w.x = pk2(sg * v0.x, sg * v0.y); w.y = pk2(sg * v0.z, sg * v0.w); w.z = pk2(sg * v1.x, sg * v1.y); w.w = pk2(sg * v1.z, sg * v1.w); cf[ks] = __builtin_bit_cast(bf16x8, w); }
        const float dk = dsk[g * 16 + c16];
        float xr = 0.f, xi = 0.f;
#pragma unroll 1
        for (int j = 0; j < ch; ++j) { const f32x2 e = E[((size_t)(b * NCHUNK + j) * S5G + g) * 64 + p]; const float nr = aw.x * xr - aw.y * xi + e.x, ni = aw.x * xi + aw.y * xr + e.y; xr = nr; xi = ni; }
        LDS_WAIT();
#pragma unroll 1
        for (int sb = 0; sb < SCH / 16; ++sb) {
#pragma unroll 4
            for (int t = 0; t < 16; ++t) { const int tg = sb * 16 + t; float ur = 0.f, ui = 0.f;
#pragma unroll
                for (int q = 0; q < 4; ++q) { const f32x4 uv = *(LAS f32x4*)(us + tg * 16 + 4 * q);
                    ur += uv.x * br[4 * q] + uv.y * br[4 * q + 1] + uv.z * br[4 * q + 2] + uv.w * br[4 * q + 3]; ui += uv.x * bi[4 * q] + uv.y * bi[4 * q + 1] + uv.z * bi[4 * q + 2] + uv.w * bi[4 * q + 3]; }
                const float nr = a.x * xr - a.y * xi + ur, ni = a.x * xi + a.y * xr + ui; xr = nr; xi = ni;
                *(LAS bf16*)(xs + t * 272 + p * 2) = (bf16)f2bf(xr); *(LAS bf16*)(xs + t * 272 + 128 + p * 2) = (bf16)f2bf(xi); }
            LDS_WAIT();
            f32x4 acc = (f32x4){0.f, 0.f, 0.f, 0.f};
#pragma unroll
            for (int ks = 0; ks < 4; ++ks) { const bf16x8 xa = *(const LAS bf16x8*)(xs + c16 * 272 + (32 * ks + 8 * kq) * 2); acc = __builtin_amdgcn_mfma_f32_16x16x32_bf16(xa, cf[ks], acc, 0, 0, 0); }
#pragma unroll
            for (int rg = 0; rg < 4; ++rg) { const int tg = sb * 16 + 4 * kq + rg; const float y = acc[rg] + dk * us[tg * 16 + c16];
                YG[(size_t)(t0 + tg) * S5CH + g * 16 + c16] = (bf16)f2bf(gelu_tanh(y)); }
            LDS_WAIT();
        }
    }
}
#ifndef OPT_S5
#define OPT_S5 1
#endif

template <bool PASS2>
__device__ __forceinline__ void s5_mfma(Frame& F) {
    const bf16* U = WSP(bf16, WS_U); const f32x2* abar = WSP(f32x2, WS_S5P); const f32x2* apow = abar + 4096; f32x2* E = WSP(f32x2, WS_S5E); const bf16* BBF = WSP(bf16, WS_S5BF);
    const float* cre = INF(20); const float* cim = INF(21); const float* dsk = INF(22); bf16* YG = WSP(bf16, WS_YG);
    LAS float* bu = (LAS float*)(F.lds + F.wave * 12800);
    LAS unsigned char* xs = (LAS unsigned char*)bu + 8448;
    const int gw = F.bid * NWAVES + F.wave, NGW = F.G * NWAVES;
    const int c16 = F.lane & 15, kq = F.lane >> 4, p = F.lane;
    for (int un = gw; un < NB * NCHUNK * S5G; un += NGW) {
        const int g = un % S5G, ch = (un / S5G) % NCHUNK, b = un / (S5G * NCHUNK); const int t0 = b * SEQ + ch * SCH;
        bf16x8 ua[4], bb[8];
#pragma unroll
        for (int tb = 0; tb < 4; ++tb) ua[tb] = *(const bf16x8*)(U + (size_t)(t0 + tb * 16 + c16) * S5CH + g * 16 + 8 * (kq & 1));
#pragma unroll
        for (int nb = 0; nb < 8; ++nb) bb[nb] = *(const bf16x8*)(BBF + ((size_t)(g * 8 + nb) * 64 + F.lane) * 8);
        const f32x2 a = abar[g * 64 + p];
        float xr = 0.f, xi = 0.f;
        bf16x8 cf[4]; float dk = 0.f;
        if (PASS2) {
            const f32x2 aw = apow[g * 64 + p];
#pragma unroll
            for (int ks = 0; ks < 4; ++ks) { const int k0 = 32 * ks + 8 * kq; const float* src = (ks < 2) ? cre + (size_t)(g * 16 + c16) * 64 + k0 : cim + (size_t)(g * 16 + c16) * 64 + (k0 - 64);
                const f32x4 v0 = *(const f32x4*)src, v1 = *(const f32x4*)(src + 4); const float sg = (ks < 2) ? 1.f : -1.f;
                u32x4 w; w.x = pk2(sg * v0.x, sg * v0.y); w.y = pk2(sg * v0.z, sg * v0.w); w.z = pk2(sg * v1.x, sg * v1.y); w.w = pk2(sg * v1.z, sg * v1.w); cf[ks] = __builtin_bit_cast(bf16x8, w); }
            dk = dsk[g * 16 + c16];
            f32x2 ev[NCHUNK - 1];
#pragma unroll
            for (int j = 0; j < NCHUNK - 1; ++j) ev[j] = (j < ch) ? E[((size_t)(b * NCHUNK + j) * S5G + g) * 64 + p] : (f32x2){0.f, 0.f};
#pragma unroll
            for (int j = 0; j < NCHUNK - 1; ++j) if (j < ch) { const float nr = aw.x * xr - aw.y * xi + ev[j].x, ni = aw.x * xi + aw.y * xr + ev[j].y; xr = nr; xi = ni; }
        }
#pragma unroll
        for (int tb = 0; tb < 4; ++tb) {
#pragma unroll
            for (int nb = 0; nb < 8; ++nb) { const f32x4 d = __builtin_amdgcn_mfma_f32_16x16x32_bf16(ua[tb], bb[nb], (f32x4){0.f, 0.f, 0.f, 0.f}, 0, 0, 0);
#pragma unroll
                for (int rg = 0; rg < 4; ++rg) bu[(4 * kq + rg) * 132 + 16 * nb + c16] = d[rg]; }
            LDS_WAIT();
#pragma unroll
            for (int t = 0; t < 16; ++t) { const float ur = bu[t * 132 + p], ui = bu[t * 132 + 64 + p];
                const float nr = a.x * xr - a.y * xi + ur, ni = a.x * xi + a.y * xr + ui; xr = nr; xi = ni;
                if (PASS2) { *(LAS bf16*)(xs + t * 272 + p * 2) = (bf16)f2bf(xr); *(LAS bf16*)(xs + t * 272 + 128 + p * 2) = (bf16)f2bf(xi); } }
            LDS_WAIT();
            if (PASS2) {
                f32x4 acc = (f32x4){0.f, 0.f, 0.f, 0.f};
#pragma unroll
                for (int ks = 0; ks < 4; ++ks) { const bf16x8 xa = *(const LAS bf16x8*)(xs + c16 * 272 + (32 * ks + 8 * kq) * 2); acc = __builtin_amdgcn_mfma_f32_16x16x32_bf16(xa, cf[ks], acc, 0, 0, 0); }
#pragma unroll
                for (int rg = 0; rg < 4; ++rg) { const size_t gi = (size_t)(t0 + tb * 16 + 4 * kq + rg) * S5CH + g * 16 + c16; const float y = acc[rg] + dk * bf2f(U[gi]); YG[gi] = (bf16)f2bf(gelu_tanh(y)); }
                LDS_WAIT();
            }
        }
        if (!PASS2) E[((size_t)(b * NCHUNK + ch) * S5G + g) * 64 + p] = (f32x2){xr, xi};
    }
}
#ifndef OPT_S5B
#define OPT_S5B 1
#endif

template <bool OUT>
__device__ __forceinline__ void s5_seg(const bf16* U, bf16* YG, LAS float* bu, LAS unsigned char* xs, const bf16x8 (&bb)[8], const bf16x8 (&cf)[4], f32x2 a, float dk, int t0, int g, int lane, float& xr, float& xi) {
    const int c16 = lane & 15, kq = lane >> 4, p = lane;
    bf16x8 ua[4], un[4];
#pragma unroll
    for (int tb = 0; tb < 4; ++tb) ua[tb] = *(const bf16x8*)(U + (size_t)(t0 + tb * 16 + c16) * S5CH + g * 16 + 8 * (kq & 1));
#pragma unroll 1
    for (int q4 = 0; q4 < 4; ++q4) {
        { const int qn = q4 < 3 ? q4 + 1 : q4;
#pragma unroll
          for (int tb = 0; tb < 4; ++tb) un[tb] = *(const bf16x8*)(U + (size_t)(t0 + qn * 64 + tb * 16 + c16) * S5CH + g * 16 + 8 * (kq & 1)); }
#pragma unroll
        for (int tb = 0; tb < 4; ++tb) {
            __builtin_amdgcn_sched_barrier(0);
            unsigned short usk[4];
            if (OUT) {
#pragma unroll
                for (int rg = 0; rg < 4; ++rg) usk[rg] = U[(size_t)(t0 + q4 * 64 + tb * 16 + 4 * kq + rg) * S5CH + g * 16 + c16]; }
#pragma unroll
            for (int nb = 0; nb < 8; ++nb) { const f32x4 d = __builtin_amdgcn_mfma_f32_16x16x32_bf16(ua[tb], bb[nb], (f32x4){0.f, 0.f, 0.f, 0.f}, 0, 0, 0);
#pragma unroll
                for (int rg = 0; rg < 4; ++rg) bu[(4 * kq + rg) * 132 + 16 * nb + c16] = d[rg]; }
            LDS_WAIT(); __builtin_amdgcn_sched_barrier(0);
#pragma unroll
            for (int t = 0; t < 16; ++t) { const float ur = bu[t * 132 + p], ui = bu[t * 132 + 64 + p];
                const float nr = a.x * xr - a.y * xi + ur, ni = a.x * xi + a.y * xr + ui; xr = nr; xi = ni;
                if (OUT) { *(LAS bf16*)(xs + t * 272 + p * 2) = (bf16)f2bf(xr); *(LAS bf16*)(xs + t * 272 + 128 + p * 2) = (bf16)f2bf(xi); } }
            LDS_WAIT(); __builtin_amdgcn_sched_barrier(0);
            if (OUT) {
                f32x4 acc = (f32x4){0.f, 0.f, 0.f, 0.f};
#pragma unroll
                for (int ks = 0; ks < 4; ++ks) { const bf16x8 xa = *(const LAS bf16x8*)(xs + c16 * 272 + (32 * ks + 8 * kq) * 2); acc = __builtin_amdgcn_mfma_f32_16x16x32_bf16(xa, cf[ks], acc, 0, 0, 0); }
#pragma unroll
                for (int rg = 0; rg < 4; ++rg) { const size_t gi = (size_t)(t0 + q4 * 64 + tb * 16 + 4 * kq + rg) * S5CH + g * 16 + c16; const float y = acc[rg] + dk * bf2f(usk[rg]); YG[gi] = (bf16)f2bf(gelu_tanh(y)); }
                LDS_WAIT();
            }
        }
#pragma unroll
        for (int tb = 0; tb < 4; ++tb) ua[tb] = un[tb];
    }
}
__device__ __forceinline__ void s5_fused(Frame& F) {
    const bf16* U = WSP(bf16, WS_U); const f32x2* abar = WSP(f32x2, WS_S5P); const f32x2* apow256 = abar + 73728; const bf16* BBF = WSP(bf16, WS_S5BF);
    const float* cre = INF(20); const float* cim = INF(21); const float* dsk = INF(22); bf16* YG = WSP(bf16, WS_YG);
    LAS float* bu = (LAS float*)(F.lds + F.wave * 12800);
    LAS unsigned char* xs = (LAS unsigned char*)bu + 8448;
    LAS f32x2* eend = (LAS f32x2*)(F.lds + 8 * 12800);
    const int c16 = F.lane & 15, kq = F.lane >> 4, p = F.lane;
    for (int pair = F.bid; pair < NB * S5G; pair += F.G) {
        const int b = pair >> 6, g = pair & 63; const int t0 = b * SEQ + F.wave * 256;
        bf16x8 bb[8];
#pragma unroll
        for (int nb = 0; nb < 8; ++nb) bb[nb] = *(const bf16x8*)(BBF + ((size_t)(g * 8 + nb) * 64 + F.lane) * 8);
        const f32x2 a = abar[g * 64 + p], aw = apow256[g * 64 + p];
        bf16x8 cf[4];
#pragma unroll
        for (int ks = 0; ks < 4; ++ks) { const int k0 = 32 * ks + 8 * kq; const float* src = (ks < 2) ? cre + (size_t)(g * 16 + c16) * 64 + k0 : cim + (size_t)(g * 16 + c16) * 64 + (k0 - 64);
            const f32x4 v0 = *(const f32x4*)src, v1 = *(const f32x4*)(src + 4); const float sg = (ks < 2) ? 1.f : -1.f;
            u32x4 w; w.x = pk2(sg * v0.x, sg * v0.y); w.y = pk2(sg * v0.z, sg * v0.w); w.z = pk2(sg * v1.x, sg * v1.y); w.w = pk2(sg * v1.z, sg * v1.w); cf[ks] = __builtin_bit_cast(bf16x8, w); }
        const float dk = dsk[g * 16 + c16];
        float xr = 0.f, xi = 0.f;
        s5_seg<false>(U, YG, bu, xs, bb, cf, a, dk, t0, g, F.lane, xr, xi);
        eend[F.wave * 64 + p] = (f32x2){xr, xi};
        __syncthreads();
        xr = 0.f; xi = 0.f;
        for (int w = 0; w < F.wave; ++w) { const f32x2 e = eend[w * 64 + p]; const float nr = aw.x * xr - aw.y * xi + e.x, ni = aw.x * xi + aw.y * xr + e.y; xr = nr; xi = ni; }
        s5_seg<true>(U, YG, bu, xs, bb, cf, a, dk, t0, g, F.lane, xr, xi);
        __syncthreads();
    }
}

__device__ __forceinline__ void attn_naive(Frame& F) {
    const bf16* Q = WSP(bf16, WS_Q); const bf16* KN = WSP(bf16, WS_KN); const bf16* KPE = WSP(bf16, WS_KPE); const bf16* VT = WSP(bf16, WS_VT); bf16* AO = WSP(bf16, WS_AO);
    const int* pos = (const int*)F.in[2]; const int* tc = WSP(int, WS_TILEC);
    LAS float* ps = (LAS float*)(F.lds + F.wave * 9216);
    LAS float* qs = ps + 2048;
    const int gw = F.bid * NWAVES + F.wave, NGW = F.G * NWAVES;
    for (int un = gw; un < NTOK * NH; un += NGW) {
        const int h = un % NH, m = un / NH, b = m / SEQ; const int qc = pos[m] >> 6;
        for (int i = F.lane; i < DQK; i += 64) qs[i] = bf2f(Q[(size_t)m * 1536 + h * DQK + i]);
        LDS_WAIT();
        float mx = -3.0e38f;
#pragma unroll 1
        for (int kt = 0; kt < 32; ++kt) {
            const int key = b * SEQ + kt * 64 + F.lane; float s = -1.0e30f;
            if (tc[b * 32 + kt] <= qc) {
                float acc = 0.f;
#pragma unroll 1
                for (int f8 = 0; f8 < 16; ++f8) { float kv[8]; unpack8(*(const u32x4*)(KN + (size_t)key * 1024 + h * 128 + f8 * 8), kv);
#pragma unroll
                    for (int j = 0; j < 8; ++j) acc += kv[j] * qs[f8 * 8 + j]; }
#pragma unroll 1
                for (int f8 = 0; f8 < 8; ++f8) { float kv[8]; unpack8(*(const u32x4*)(KPE + (size_t)key * 64 + f8 * 8), kv);
#pragma unroll
                    for (int j = 0; j < 8; ++j) acc += kv[j] * qs[128 + f8 * 8 + j]; }
                if ((pos[key] >> 6) <= qc) s = acc;
            }
            ps[kt * 64 + F.lane] = s; mx = fmaxf(mx, s);
        }
#pragma unroll
        for (int o = 1; o < 64; o <<= 1) mx = fmaxf(mx, __shfl_xor(mx, o));
        float sum = 0.f;
#pragma unroll 1
        for (int kt = 0; kt < 32; ++kt) { const float p = exp2f(ps[kt * 64 + F.lane] - mx); sum += p; ps[kt * 64 + F.lane] = bf2f(f2bf(p)); }
        sum = wave_sum(sum);
        LDS_WAIT();
        float o0 = 0.f, o1 = 0.f;
        const bf16* v0 = VT + (size_t)(h * 128 + F.lane) * NTOK + b * SEQ; const bf16* v1 = v0 + (size_t)64 * NTOK;
#pragma unroll 1
        for (int k8 = 0; k8 < SEQ / 8; ++k8) { float a[8], c[8]; unpack8(*(const u32x4*)(v0 + k8 * 8), a); unpack8(*(const u32x4*)(v1 + k8 * 8), c);
#pragma unroll
            for (int j = 0; j < 8; ++j) { const float p = ps[k8 * 8 + j]; o0 += p * a[j]; o1 += p * c[j]; } }
        const float inv = 1.0f / sum;
        AO[(size_t)m * 1024 + h * 128 + F.lane] = (bf16)f2bf(o0 * inv); AO[(size_t)m * 1024 + h * 128 + 64 + F.lane] = (bf16)f2bf(o1 * inv);
        LDS_WAIT();
    }
}

namespace att {
typedef float f32x16 __attribute__((ext_vector_type(16)));
typedef short s16x4 __attribute__((ext_vector_type(4)));
constexpr int KROW = 400, VROW = 136, KT_BYTES = 64 * KROW, VT_BYTES = 128 * VROW, KC_BYTES = 256, BUF_BYTES = KT_BYTES + VT_BYTES + KC_BYTES;
__device__ __forceinline__ unsigned cvtpk(float lo, float hi) { unsigned r; asm volatile("v_cvt_pk_bf16_f32 %0, %1, %2" : "=v"(r) : "v"(lo), "v"(hi)); return r; }
struct Stage { u32x4 r0, r1, r2, r3, r4; int kc; };
__device__ __forceinline__ void issue(Stage& st, const bf16* KN, const bf16* KPE, const bf16* VT, const int* pos, int tok0, int h, int tid) {
    st.r0 = *(const u32x4*)(KN + (size_t)(tok0 + (tid >> 4)) * 1024 + h * 128 + (tid & 15) * 8);
    st.r1 = *(const u32x4*)(KN + (size_t)(tok0 + 32 + (tid >> 4)) * 1024 + h * 128 + (tid & 15) * 8);
    st.r2 = *(const u32x4*)(KPE + (size_t)(tok0 + (tid >> 3)) * 64 + (tid & 7) * 8);
    st.r3 = *(const u32x4*)(VT + (size_t)(h * 128 + (tid >> 3)) * NTOK + tok0 + (tid & 7) * 8);
    st.r4 = *(const u32x4*)(VT + (size_t)(h * 128 + 64 + (tid >> 3)) * NTOK + tok0 + (tid & 7) * 8);
    st.kc = (tid < 64) ? (pos[tok0 + tid] >> 6) : 0;
}
__device__ __forceinline__ void commit(const Stage& st, LAS unsigned char* buf, int tid) {
    *(LAS u32x4*)(buf + (tid >> 4) * KROW + (tid & 15) * 16) = st.r0;
    *(LAS u32x4*)(buf + (32 + (tid >> 4)) * KROW + (tid & 15) * 16) = st.r1;
    *(LAS u32x4*)(buf + (tid >> 3) * KROW + 256 + (tid & 7) * 16) = st.r2;
    LAS unsigned char* vb = buf + KT_BYTES;
    *(LAS u32x2*)(vb + (tid >> 3) * VROW + (tid & 7) * 16) = (u32x2){st.r3.x, st.r3.y}; *(LAS u32x2*)(vb + (tid >> 3) * VROW + (tid & 7) * 16 + 8) = (u32x2){st.r3.z, st.r3.w};
    *(LAS u32x2*)(vb + (64 + (tid >> 3)) * VROW + (tid & 7) * 16) = (u32x2){st.r4.x, st.r4.y}; *(LAS u32x2*)(vb + (64 + (tid >> 3)) * VROW + (tid & 7) * 16 + 8) = (u32x2){st.r4.z, st.r4.w};
    if (tid < 64) *(LAS int*)(buf + KT_BYTES + VT_BYTES + tid * 4) = st.kc;
}
__device__ __forceinline__ void attn_phase(Frame& F) {
    const bf16* Q = WSP(bf16, WS_Q); const bf16* KN = WSP(bf16, WS_KN); const bf16* KPE = WSP(bf16, WS_KPE); const bf16* VT = WSP(bf16, WS_VT); bf16* AO = WSP(bf16, WS_AO);
    const int* pos = (const int*)F.in[2]; const int* tc = WSP(int, WS_TILEC);
    const int tid = F.tid, lane = F.lane, hh = lane >> 5, ql = lane & 31, half = F.wave >> 2, wq = F.wave & 3;
    for (int unit = F.bid; unit < NB * NH * 8; unit += F.G) {
        const int j = unit & 7, bh = unit >> 3, b = bh >> 3, h = bh & 7;
        const int qblk = half ? (15 - j) : j;
        const int qrow = b * SEQ + qblk * 128 + wq * 32 + ql;
        bf16x8 qf[12];
#pragma unroll
        for (int ks = 0; ks < 12; ++ks) qf[ks] = *(const bf16x8*)(Q + (size_t)qrow * 1536 + h * DQK + 16 * ks + 8 * hh);
        const int qc = pos[qrow] >> 6;
        int qcmin = qc;
#pragma unroll
        for (int o = 1; o < 32; o <<= 1) { const int t = __shfl_xor(qcmin, o); qcmin = t < qcmin ? t : qcmin; }
        qcmin = __builtin_amdgcn_readfirstlane(qcmin);
        const int tmm = (lane < 32) ? tc[b * 32 + lane] : tc[128 + b * 32 + (lane - 32)];
#define TMIN(k) __builtin_amdgcn_readlane(tmm, (k))
#define TMAX(k) __builtin_amdgcn_readlane(tmm, 32 + (k))
        const int qmA0 = TMAX(2 * j), qmA1 = TMAX(2 * j + 1), qmB0 = TMAX(2 * (15 - j)), qmB1 = TMAX(2 * (15 - j) + 1);
        const int qmaxA = qmA0 > qmA1 ? qmA0 : qmA1, qmaxB = qmB0 > qmB1 ? qmB0 : qmB1;
        const int myqmax = half ? qmaxB : qmaxA, anyqmax = qmaxA > qmaxB ? qmaxA : qmaxB;
        f32x16 O[4];
#pragma unroll
        for (int d = 0; d < 4; ++d)
#pragma unroll
            for (int r = 0; r < 16; ++r) O[d][r] = 0.f;
        float m = -1.0e30f, l = 0.f;
        int kt = 0; while (kt < 32 && TMIN(kt) > anyqmax) ++kt;
        Stage st;
        if (kt < 32) { issue(st, KN, KPE, VT, pos, b * SEQ + kt * 64, h, tid); commit(st, F.lds, tid); }
        __syncthreads();
        int bufi = 0;
        while (kt < 32) {
            int ktn = kt + 1; while (ktn < 32 && TMIN(ktn) > anyqmax) ++ktn;
            if (ktn < 32) issue(st, KN, KPE, VT, pos, b * SEQ + ktn * 64, h, tid);
            if (TMIN(kt) <= myqmax) {
                const LAS unsigned char* kb_ = F.lds + bufi * BUF_BYTES; const LAS unsigned char* vb_ = kb_ + KT_BYTES; const LAS unsigned char* kcb = vb_ + VT_BYTES;
                f32x16 S0, S1;
#pragma unroll
                for (int r = 0; r < 16; ++r) { S0[r] = 0.f; S1[r] = 0.f; }
#pragma unroll
                for (int ks = 0; ks < 12; ++ks) {
                    const bf16x8 k0 = *(const LAS bf16x8*)(kb_ + ql * KROW + (16 * ks + 8 * hh) * 2);
                    const bf16x8 k1 = *(const LAS bf16x8*)(kb_ + (32 + ql) * KROW + (16 * ks + 8 * hh) * 2);
                    S0 = __builtin_amdgcn_mfma_f32_32x32x16_bf16(k0, qf[ks], S0, 0, 0, 0);
                    S1 = __builtin_amdgcn_mfma_f32_32x32x16_bf16(k1, qf[ks], S1, 0, 0, 0);
                }
                if (TMAX(kt) > qcmin) {
#pragma unroll
                    for (int g = 0; g < 4; ++g) {
                        const u32x4 c0 = *(const LAS u32x4*)(kcb + (8 * g + 4 * hh) * 4), c1 = *(const LAS u32x4*)(kcb + (32 + 8 * g + 4 * hh) * 4);
#pragma unroll
                        for (int i = 0; i < 4; ++i) { if ((int)c0[i] > qc) S0[4 * g + i] = -1.0e30f; if ((int)c1[i] > qc) S1[4 * g + i] = -1.0e30f; }
                    }
                }
                float mx = S0[0];
#pragma unroll
                for (int r = 1; r < 16; ++r) mx = fmaxf(mx, S0[r]);
#pragma unroll
                for (int r = 0; r < 16; ++r) mx = fmaxf(mx, S1[r]);
                mx = fmaxf(mx, __shfl_xor(mx, 32));
                const float mn = fmaxf(m, mx), alpha = __builtin_amdgcn_exp2f(m - mn); m = mn;
                float ps = 0.f;
#pragma unroll
                for (int r = 0; r < 16; ++r) { S0[r] = __builtin_amdgcn_exp2f(S0[r] - mn); S1[r] = __builtin_amdgcn_exp2f(S1[r] - mn); ps += S0[r] + S1[r]; }
                l = l * alpha + ps;
                if (__any(alpha != 1.0f)) {
#pragma unroll
                    for (int d = 0; d < 4; ++d)
#pragma unroll
                        for (int r = 0; r < 16; ++r) O[d][r] *= alpha;
                }
                bf16x8 pf[2][2];
#pragma unroll
                for (int s2 = 0; s2 < 2; ++s2) {
                    u32x4 w0, w1;
                    w0.x = cvtpk(S0[8 * s2 + 0], S0[8 * s2 + 1]); w0.y = cvtpk(S0[8 * s2 + 2], S0[8 * s2 + 3]); w0.z = cvtpk(S0[8 * s2 + 4], S0[8 * s2 + 5]); w0.w = cvtpk(S0[8 * s2 + 6], S0[8 * s2 + 7]);
                    w1.x = cvtpk(S1[8 * s2 + 0], S1[8 * s2 + 1]); w1.y = cvtpk(S1[8 * s2 + 2], S1[8 * s2 + 3]); w1.z = cvtpk(S1[8 * s2 + 4], S1[8 * s2 + 5]); w1.w = cvtpk(S1[8 * s2 + 6], S1[8 * s2 + 7]);
                    pf[0][s2] = __builtin_bit_cast(bf16x8, w0); pf[1][s2] = __builtin_bit_cast(bf16x8, w1);
                }
#pragma unroll
                for (int db = 0; db < 4; ++db)
#pragma unroll
                    for (int kb = 0; kb < 2; ++kb)
#pragma unroll
                        for (int s2 = 0; s2 < 2; ++s2) {
                            const LAS unsigned char* vp = vb_ + (32 * db + ql) * VROW + (32 * kb + 16 * s2 + 4 * hh) * 2;
                            const s16x4 lo = *(const LAS s16x4*)vp, hi = *(const LAS s16x4*)(vp + 16);
                            const bf16x8 a = __builtin_shufflevector(lo, hi, 0, 1, 2, 3, 4, 5, 6, 7);
                            O[db] = __builtin_amdgcn_mfma_f32_32x32x16_bf16(a, pf[kb][s2], O[db], 0, 0, 0);
                        }
            }
            if (ktn < 32) commit(st, F.lds + (bufi ^ 1) * BUF_BYTES, tid);
            __syncthreads();
            kt = ktn; bufi ^= 1;
        }
        l += __shfl_xor(l, 32);
        const float inv = 1.0f / l;
        bf16* op = AO + (size_t)qrow * 1024 + h * 128;
#pragma unroll
        for (int db = 0; db < 4; ++db)
#pragma unroll
            for (int g = 0; g < 4; ++g) {
                const int d0 = 32 * db + 8 * g + 4 * hh;
                *(u32x2*)(op + d0) = (u32x2){pk2(O[db][4 * g] * inv, O[db][4 * g + 1] * inv), pk2(O[db][4 * g + 2] * inv, O[db][4 * g + 3] * inv)};
            }
    }
}
}
namespace att3 {
using att::f32x16; using att::s16x4; using att::cvtpk; using att::Stage; using att::issue; using att::commit;
using att::KROW; using att::VROW; using att::KT_BYTES; using att::VT_BYTES; using att::BUF_BYTES;
__device__ __forceinline__ void store_rows(bf16* AO, int qrow, int h, int hh, const f32x16 (&O)[4], float l) {
    l += __shfl_xor(l, 32);
    const float inv = 1.0f / l;
    bf16* op = AO + (size_t)qrow * 1024 + h * 128;
#pragma unroll
    for (int db = 0; db < 4; ++db)
#pragma unroll
        for (int g = 0; g < 4; ++g) { const int d0 = 32 * db + 8 * g + 4 * hh;
            *(u32x2*)(op + d0) = (u32x2){pk2(O[db][4 * g] * inv, O[db][4 * g + 1] * inv), pk2(O[db][4 * g + 2] * inv, O[db][4 * g + 3] * inv)}; }
}
__device__ __forceinline__ void attn_phase(Frame& F) {
    const bf16* Q = WSP(bf16, WS_Q); const bf16* KN = WSP(bf16, WS_KN); const bf16* KPE = WSP(bf16, WS_KPE); const bf16* VT = WSP(bf16, WS_VT); bf16* AO = WSP(bf16, WS_AO);
    const int* pos = (const int*)F.in[2]; const int* tc = WSP(int, WS_TILEC);
    const int tid = F.tid, lane = F.lane, hh = lane >> 5, ql = lane & 31, half = F.wave >> 2, wq = F.wave & 3;
    for (int unit = F.bid; unit < NB * NH * 8; unit += F.G) {
        const int j = unit & 7, bh = unit >> 3, b = bh >> 3, h = bh & 7;
        const int qrowH = b * SEQ + (15 - j) * 128 + wq * 32 + ql;
        int qrow = half ? qrowH : b * SEQ + j * 128 + wq * 32 + ql;
        bf16x8 qf[12];
#pragma unroll
        for (int ks = 0; ks < 12; ++ks) qf[ks] = *(const bf16x8*)(Q + (size_t)qrow * 1536 + h * DQK + 16 * ks + 8 * hh);
        int qc = pos[qrow] >> 6;
        int qcmin = qc;
#pragma unroll
        for (int o = 1; o < 32; o <<= 1) { const int t = __shfl_xor(qcmin, o); qcmin = t < qcmin ? t : qcmin; }
        qcmin = __builtin_amdgcn_readfirstlane(qcmin);
        const int tmm = (lane < 32) ? tc[b * 32 + lane] : tc[128 + b * 32 + (lane - 32)];
        const int qmA0 = TMAX(2 * j), qmA1 = TMAX(2 * j + 1), qmB0 = TMAX(2 * (15 - j)), qmB1 = TMAX(2 * (15 - j) + 1);
        const int qmaxA = qmA0 > qmA1 ? qmA0 : qmA1, qmaxB = qmB0 > qmB1 ? qmB0 : qmB1;
        const int anyqmax = qmaxA > qmaxB ? qmaxA : qmaxB;
        int lastA = -1;
#pragma unroll 1
        for (int k = 0; k < 32; ++k) if (TMIN(k) <= qmaxA) lastA = k;
        f32x16 O[4];
#pragma unroll
        for (int d = 0; d < 4; ++d)
#pragma unroll
            for (int r = 0; r < 16; ++r) O[d][r] = 0.f;
        float m = -1.0e30f, l = 0.f;
        int kt = 0; while (kt < 32 && TMIN(kt) > anyqmax) ++kt;
        Stage st;
        if (kt < 32) { issue(st, KN, KPE, VT, pos, b * SEQ + kt * 64, h, tid); commit(st, F.lds, tid); }
        __syncthreads();
        int bufi = 0;
        while (kt < 32 && kt <= lastA) {
            int ktn = kt + 1; while (ktn < 32 && TMIN(ktn) > anyqmax) ++ktn;
            if (ktn < 32) issue(st, KN, KPE, VT, pos, b * SEQ + ktn * 64, h, tid);
            const LAS unsigned char* kb_ = F.lds + bufi * BUF_BYTES; const LAS unsigned char* vb_ = kb_ + KT_BYTES; const LAS unsigned char* kcb = vb_ + VT_BYTES;
            if (TMIN(kt) <= (half ? qmaxB : qmaxA)) {
                f32x16 S0, S1;
#pragma unroll
                for (int r = 0; r < 16; ++r) { S0[r] = 0.f; S1[r] = 0.f; }
#pragma unroll
                for (int ks = 0; ks < 12; ++ks) {
                    const bf16x8 k0 = *(const LAS bf16x8*)(kb_ + ql * KROW + (16 * ks + 8 * hh) * 2);
                    const bf16x8 k1 = *(const LAS bf16x8*)(kb_ + (32 + ql) * KROW + (16 * ks + 8 * hh) * 2);
                    S0 = __builtin_amdgcn_mfma_f32_32x32x16_bf16(k0, qf[ks], S0, 0, 0, 0);
                    S1 = __builtin_amdgcn_mfma_f32_32x32x16_bf16(k1, qf[ks], S1, 0, 0, 0);
                }
                if (TMAX(kt) > qcmin) {
#pragma unroll
                    for (int g = 0; g < 4; ++g) {
                        const u32x4 c0 = *(const LAS u32x4*)(kcb + (8 * g + 4 * hh) * 4), c1 = *(const LAS u32x4*)(kcb + (32 + 8 * g + 4 * hh) * 4);
#pragma unroll
                        for (int i = 0; i < 4; ++i) { if ((int)c0[i] > qc) S0[4 * g + i] = -1.0e30f; if ((int)c1[i] > qc) S1[4 * g + i] = -1.0e30f; }
                    }
                }
                float mx = S0[0];
#pragma unroll
                for (int r = 1; r < 16; ++r) mx = fmaxf(mx, S0[r]);
#pragma unroll
                for (int r = 0; r < 16; ++r) mx = fmaxf(mx, S1[r]);
                mx = fmaxf(mx, __shfl_xor(mx, 32));
                const float mn = fmaxf(m, mx), alpha = __builtin_amdgcn_exp2f(m - mn); m = mn;
                float ps = 0.f;
#pragma unroll
                for (int r = 0; r < 16; ++r) { S0[r] = __builtin_amdgcn_exp2f(S0[r] - mn); S1[r] = __builtin_amdgcn_exp2f(S1[r] - mn); ps += S0[r] + S1[r]; }
                l = l * alpha + ps;
                if (__any(alpha != 1.0f)) {
#pragma unroll
                    for (int d = 0; d < 4; ++d)
#pragma unroll
                        for (int r = 0; r < 16; ++r) O[d][r] *= alpha;
                }
                bf16x8 pf[2][2];
#pragma unroll
                for (int s2 = 0; s2 < 2; ++s2) {
                    u32x4 w0, w1;
                    w0.x = cvtpk(S0[8 * s2 + 0], S0[8 * s2 + 1]); w0.y = cvtpk(S0[8 * s2 + 2], S0[8 * s2 + 3]); w0.z = cvtpk(S0[8 * s2 + 4], S0[8 * s2 + 5]); w0.w = cvtpk(S0[8 * s2 + 6], S0[8 * s2 + 7]);
                    w1.x = cvtpk(S1[8 * s2 + 0], S1[8 * s2 + 1]); w1.y = cvtpk(S1[8 * s2 + 2], S1[8 * s2 + 3]); w1.z = cvtpk(S1[8 * s2 + 4], S1[8 * s2 + 5]); w1.w = cvtpk(S1[8 * s2 + 6], S1[8 * s2 + 7]);
                    pf[0][s2] = __builtin_bit_cast(bf16x8, w0); pf[1][s2] = __builtin_bit_cast(bf16x8, w1);
                }
#pragma unroll
                for (int kb = 0; kb < 2; ++kb)
#pragma unroll
                    for (int s2 = 0; s2 < 2; ++s2)
#pragma unroll
                        for (int db = 0; db < 4; ++db) {
                            const LAS unsigned char* vp = vb_ + (32 * db + ql) * VROW + (32 * kb + 16 * s2 + 4 * hh) * 2;
                            const s16x4 lo = *(const LAS s16x4*)vp, hi = *(const LAS s16x4*)(vp + 16);
                            const bf16x8 a = __builtin_shufflevector(lo, hi, 0, 1, 2, 3, 4, 5, 6, 7);
                            O[db] = __builtin_amdgcn_mfma_f32_32x32x16_bf16(a, pf[kb][s2], O[db], 0, 0, 0);
                        }
            }
            if (ktn < 32) commit(st, F.lds + (bufi ^ 1) * BUF_BYTES, tid);
            __syncthreads();
            kt = ktn; bufi ^= 1;
        }
        if (half == 0) {
            store_rows(AO, qrow, h, hh, O, l);
            qrow = qrowH;
#pragma unroll
            for (int ks = 0; ks < 12; ++ks) qf[ks] = *(const bf16x8*)(Q + (size_t)qrow * 1536 + h * DQK + 16 * ks + 8 * hh);
            qc = pos[qrow] >> 6; qcmin = qc;
#pragma unroll
            for (int o = 1; o < 32; o <<= 1) { const int t = __shfl_xor(qcmin, o); qcmin = t < qcmin ? t : qcmin; }
            qcmin = __builtin_amdgcn_readfirstlane(qcmin);
#pragma unroll
            for (int d = 0; d < 4; ++d)
#pragma unroll
                for (int r = 0; r < 16; ++r) O[d][r] = 0.f;
            m = -1.0e30f; l = 0.f;
        }
        while (kt < 32) {
            int ktn = kt + 1; while (ktn < 32 && TMIN(ktn) > anyqmax) ++ktn;
            if (ktn < 32) issue(st, KN, KPE, VT, pos, b * SEQ + ktn * 64, h, tid);
            const LAS unsigned char* kb_ = F.lds + bufi * BUF_BYTES; const LAS unsigned char* vb_ = kb_ + KT_BYTES; const LAS unsigned char* kcb = vb_ + VT_BYTES;
            if (TMIN(kt) <= qmaxB) {
                const int kb = half;
                f32x16 S0;
#pragma unroll
                for (int r = 0; r < 16; ++r) S0[r] = 0.f;
#pragma unroll
                for (int ks = 0; ks < 12; ++ks) {
                    const bf16x8 k0 = *(const LAS bf16x8*)(kb_ + (32 * kb + ql) * KROW + (16 * ks + 8 * hh) * 2);
                    S0 = __builtin_amdgcn_mfma_f32_32x32x16_bf16(k0, qf[ks], S0, 0, 0, 0);
                }
                if (TMAX(kt) > qcmin) {
#pragma unroll
                    for (int g = 0; g < 4; ++g) { const u32x4 c0 = *(const LAS u32x4*)(kcb + (32 * kb + 8 * g + 4 * hh) * 4);
#pragma unroll
                        for (int i = 0; i < 4; ++i) if ((int)c0[i] > qc) S0[4 * g + i] = -1.0e30f; }
                }
                float mx = S0[0];
#pragma unroll
                for (int r = 1; r < 16; ++r) mx = fmaxf(mx, S0[r]);
                mx = fmaxf(mx, __shfl_xor(mx, 32));
                const float mn = fmaxf(m, mx), alpha = __builtin_amdgcn_exp2f(m - mn); m = mn;
                float ps = 0.f;
#pragma unroll
                for (int r = 0; r < 16; ++r) { S0[r] = __builtin_amdgcn_exp2f(S0[r] - mn); ps += S0[r]; }
                l = l * alpha + ps;
                if (__any(alpha != 1.0f)) {
#pragma unroll
                    for (int d = 0; d < 4; ++d)
#pragma unroll
                        for (int r = 0; r < 16; ++r) O[d][r] *= alpha;
                }
                bf16x8 pf[2];
#pragma unroll
                for (int s2 = 0; s2 < 2; ++s2) { u32x4 w0;
                    w0.x = cvtpk(S0[8 * s2 + 0], S0[8 * s2 + 1]); w0.y = cvtpk(S0[8 * s2 + 2], S0[8 * s2 + 3]); w0.z = cvtpk(S0[8 * s2 + 4], S0[8 * s2 + 5]); w0.w = cvtpk(S0[8 * s2 + 6], S0[8 * s2 + 7]);
                    pf[s2] = __builtin_bit_cast(bf16x8, w0); }
#pragma unroll
                for (int s2 = 0; s2 < 2; ++s2)
#pragma unroll
                    for (int db = 0; db < 4; ++db) {
                        const LAS unsigned char* vp = vb_ + (32 * db + ql) * VROW + (32 * kb + 16 * s2 + 4 * hh) * 2;
                        const s16x4 lo = *(const LAS s16x4*)vp, hi = *(const LAS s16x4*)(vp + 16);
                        const bf16x8 a = __builtin_shufflevector(lo, hi, 0, 1, 2, 3, 4, 5, 6, 7);
                        O[db] = __builtin_amdgcn_mfma_f32_32x32x16_bf16(a, pf[s2], O[db], 0, 0, 0);
                    }
            }
            if (ktn < 32) commit(st, F.lds + (bufi ^ 1) * BUF_BYTES, tid);
            __syncthreads();
            kt = ktn; bufi ^= 1;
        }
        LAS float* xb = (LAS float*)F.lds + wq * (66 * 64);
        if (half == 0) {
#pragma unroll
            for (int d = 0; d < 4; ++d)
#pragma unroll
                for (int r = 0; r < 16; ++r) xb[(16 * d + r) * 64 + lane] = O[d][r];
            xb[64 * 64 + lane] = m; xb[65 * 64 + lane] = l;
        }
        __syncthreads();
        if (half == 1) {
            const float m2 = xb[64 * 64 + lane], l2 = xb[65 * 64 + lane];
            const float mn = fmaxf(m, m2), a1 = __builtin_amdgcn_exp2f(m - mn), a2 = __builtin_amdgcn_exp2f(m2 - mn);
#pragma unroll
            for (int d = 0; d < 4; ++d)
#pragma unroll
                for (int r = 0; r < 16; ++r) O[d][r] = O[d][r] * a1 + xb[(16 * d + r) * 64 + lane] * a2;
            l = l * a1 + l2 * a2;
            store_rows(AO, qrowH, h, hh, O, l);
        }
        __syncthreads();
    }
}
}
#ifndef OPT_ATTN
#define OPT_ATTN 1
#endif

template <bool BLK> __device__ __forceinline__ void p8_tok(Frame& F, int m0) {
    const int gw = F.bid * NWAVES + F.wave, NGW = F.G * NWAVES;
    const float* x = INF(0); const float* gpost = INF(6); const float* gpre = INF(7); const float* mod = WSP(float, WS_MOD); const bf16* MX = WSP(bf16, WS_MIXED);
    bf16* H = WSP(bf16, WS_H); bf16* HL = WSP(bf16, WS_H2LO);
    for (int m = BLK ? m0 + F.wave * 4 : gw; m < (BLK ? m0 + F.wave * 4 + 4 : NTOK); m += (BLK ? 1 : NGW)) {
        const int b = m / SEQ; const u32x2* mr = (const u32x2*)(MX + (size_t)m * DM) + F.lane; const f32x4* xr = (const f32x4*)(x + (size_t)m * DM) + F.lane;
        f32x4 v[8]; float s = 0.f;
#pragma unroll
        for (int j = 0; j < 8; ++j) { const u32x2 w = mr[64 * j]; v[j] = (f32x4){__uint_as_float(w.x << 16), __uint_as_float(w.x & 0xffff0000u), __uint_as_float(w.y << 16), __uint_as_float(w.y & 0xffff0000u)}; s += (v[j].x * v[j].x + v[j].y * v[j].y) + (v[j].z * v[j].z + v[j].w * v[j].w); }
        const float rs = 1.0f / sqrtf(wave_sum(s) * (1.0f / DM) + EPS);
        const float* mb = mod + b * 12288; float s2 = 0.f;
        f32x4* xo = (f32x4*)(F.out + (size_t)m * DM) + F.lane;
#pragma unroll
        for (int j = 0; j < 8; ++j) { const int k = 4 * F.lane + 256 * j; const f32x4 gg = *(const f32x4*)(gpost + k), gt = *(const f32x4*)(mb + 2 * DM + k);
            v[j] = xr[64 * j] + gt * (v[j] * rs * gg); xo[64 * j] = v[j]; s2 += (v[j].x * v[j].x + v[j].y * v[j].y) + (v[j].z * v[j].z + v[j].w * v[j].w); }
        const float rs2 = 1.0f / sqrtf(wave_sum(s2) * (1.0f / DM) + EPS);
        u32x2* oh = (u32x2*)(H + (size_t)m * DM) + F.lane; u32x2* ol = (u32x2*)(HL + (size_t)m * DM) + F.lane;
#pragma unroll
        for (int j = 0; j < 8; ++j) { const int k = 4 * F.lane + 256 * j; const f32x4 gg = *(const f32x4*)(gpre + k), s1 = *(const f32x4*)(mb + 4 * DM + k), s0 = *(const f32x4*)(mb + 3 * DM + k);
            const f32x4 h = v[j] * rs2 * gg * (1.0f + s1) + s0;
            const unsigned h0 = f2bf(h.x), h1 = f2bf(h.y), h2 = f2bf(h.z), h3 = f2bf(h.w);
            oh[64 * j] = (u32x2){h0 | (h1 << 16), h2 | (h3 << 16)};
            ol[64 * j] = (u32x2){pk2(h.x - bf2f(h0), h.y - bf2f(h1)), pk2(h.z - bf2f(h2), h.w - bf2f(h3))}; }
    }
}
__device__ __forceinline__ void p8b_route(Frame& F) {
    const bf16* H = WSP(bf16, WS_H); const bf16* HL = WSP(bf16, WS_H2LO); const bf16* WH = WSP(bf16, WS_WR); const bf16* WL = WH + 64 * DM;
    const float* rbias = INF(28); unsigned* gcnt = WSP(unsigned, WS_CTL) + CW_CNT; int* rowtok = WSP(int, WS_ROWTOK); unsigned* tinfo = WSP(unsigned, WS_TOKINFO); float* tw = (float*)(tinfo + NTOK * 8);
    LAS float* red = (LAS float*)F.lds;
    LAS float* lg = red + 8192;
    LAS int* lcnt = (LAS int*)(lg + 2048);
    LAS int* lbase = lcnt + 64;
    ThinArgs t; t.A[0] = H; t.B[0] = WH; t.A[1] = HL; t.B[1] = WH; t.A[2] = H; t.B[2] = WL;
    for (int blk = F.bid; blk < NTOK / 32; blk += F.G) {
        const int m0 = blk * 32;
        p8_tok<true>(F, m0); VM_WAIT(); __syncthreads();
        if (F.tid < 64) lcnt[F.tid] = 0;
#if OPT_THIN
        thin_mfma_partials<true>(F, H, HL, WH, WL, m0, red);
        __syncthreads();
        { const int row32 = F.tid >> 4, c4 = (F.tid & 15) * 4; *(LAS f32x4*)(lg + row32 * 64 + c4) = thin_reduce4(red, row32, c4); }
        __syncthreads();
#else
        if (F.tid < 256) { const int r = F.tid >> 3, c8 = (F.tid & 7) * 8; float acc[8]; thin_dot8<3>(t, m0 + r, c8, acc);
#pragma unroll
            for (int j = 0; j < 8; ++j) lg[r * 64 + c8 + j] = acc[j]; }
        __syncthreads();
#endif
        int sel_e[4]; int sel_pos[4]; float sel_w[4]; int sel_k[4]; bool sel_f[4];
#pragma unroll
        for (int q = 0; q < 4; ++q) {
            const int r = F.wave * 4 + q, e = F.lane; const float score = 1.0f / (1.0f + expf(-lg[r * 64 + e])); const float sel = score + rbias[e];
            float m1 = sel;
#pragma unroll
            for (int o = 1; o < 8; o <<= 1) m1 = fmaxf(m1, __shfl_xor(m1, o));
            int i1 = (sel == m1) ? e : 64;
#pragma unroll
            for (int o = 1; o < 8; o <<= 1) { const int t2 = __shfl_xor(i1, o); i1 = t2 < i1 ? t2 : i1; }
            float m2 = (e == i1) ? -3.0e38f : sel;
#pragma unroll
            for (int o = 1; o < 8; o <<= 1) m2 = fmaxf(m2, __shfl_xor(m2, o));
            const float gs = m1 + m2; const int g = e >> 3; int grank = 0;
#pragma unroll
            for (int g2 = 0; g2 < 8; ++g2) { const float o = __uint_as_float((unsigned)__builtin_amdgcn_readlane((int)__float_as_uint(gs), g2 * 8)); grank += (o > gs || (o == gs && g2 < g)) ? 1 : 0; }
            const float v = (grank < TOPG) ? sel : -INFINITY; int rank = 0;
#pragma unroll
            for (int e2 = 0; e2 < 64; ++e2) { const float o = __uint_as_float((unsigned)__builtin_amdgcn_readlane((int)__float_as_uint(v), e2)); rank += (o > v || (o == v && e2 < e)) ? 1 : 0; }
            const bool chosen = rank < TOPK; const float wsum = wave_sum(chosen ? score : 0.f);
            const unsigned long long bal = __ballot(chosen); const int kidx = __popcll(bal & ((1ull << e) - 1ull));
            sel_f[q] = chosen; sel_e[q] = e; sel_k[q] = kidx; sel_w[q] = score / wsum * 2.5f; sel_pos[q] = chosen ? __hip_atomic_fetch_add(&lcnt[e], 1, __ATOMIC_RELAXED, __HIP_MEMORY_SCOPE_WORKGROUP) : 0;
        }
        __syncthreads();
        if (F.tid < 64) { const int n = lcnt[F.tid]; lbase[F.tid] = n ? (int)atomicAdd(&gcnt[F.tid], (unsigned)n) : 0; }
        __syncthreads();
#pragma unroll
        for (int q = 0; q < 4; ++q) if (sel_f[q]) { const int tok = m0 + F.wave * 4 + q, e = sel_e[q], pos = lbase[e] + sel_pos[q];
            rowtok[(size_t)e * NTOK + pos] = tok; tinfo[tok * 8 + sel_k[q]] = ((unsigned)e << 16) | (unsigned)pos; tw[tok * 8 + sel_k[q]] = sel_w[q]; }
        __syncthreads();
    }
}
struct P9Row { u32x2 mr[8]; f32x4 xr[8]; };
__device__ __forceinline__ void p9_load(P9Row& R, const bf16* MX, const float* x, int m, int lane) {
    const u32x2* mr = (const u32x2*)(MX + (size_t)m * DM) + lane; const f32x4* xr = (const f32x4*)(x + (size_t)m * DM) + lane;
#pragma unroll
    for (int j = 0; j < 8; ++j) { R.mr[j] = mr[64 * j]; R.xr[j] = xr[64 * j]; }
}
constexpr int LO_PITCH = 4112;
__device__ __forceinline__ void p9_route_lds(Frame& F) {
    const float* x = INF(0); const float* gpost = INF(6); const float* gpre = INF(7); const float* mod = WSP(float, WS_MOD); const bf16* MX = WSP(bf16, WS_MIXED);
    bf16* H = WSP(bf16, WS_H); const bf16* WH = WSP(bf16, WS_WR); const bf16* WL = WH + 64 * DM;
    const float* rbias = INF(28); unsigned* gcnt = WSP(unsigned, WS_CTL) + CW_CNT; int* rowtok = WSP(int, WS_ROWTOK); unsigned* tinfo = WSP(unsigned, WS_TOKINFO); float* tw = (float*)(tinfo + NTOK * 8);
    LAS unsigned char* lo = F.lds;
    LAS float* red = (LAS float*)(F.lds + 16 * LO_PITCH);
    LAS float* lg = red + 8192;
    LAS int* lcnt = (LAS int*)(lg + 1024);
    LAS int* lbase = lcnt + 64;
    const int r16 = F.lane & 15, kq = F.lane >> 4;
    for (int blk = F.bid; blk < NTOK / 32; blk += F.G) {
        const int m0 = blk * 32;
        if (F.tid < 64) lcnt[F.tid] = 0;
        int sel_e[4]; int sel_pos[4]; float sel_w[4]; int sel_k[4]; bool sel_f[4];
        P9Row Ra, Rb; p9_load(Ra, MX, x, m0 + 2 * F.wave, F.lane); p9_load(Rb, MX, x, m0 + 2 * F.wave + 1, F.lane);
        const float rb_e = rbias[F.lane];
#pragma unroll
        for (int pass = 0; pass < 2; ++pass) {
            const int r0 = m0 + 16 * pass;
#pragma unroll
            for (int q = 0; q < 2; ++q) {
                const int rl = 2 * F.wave + q, m = r0 + rl, b = m / SEQ;
                const P9Row& R = q ? Rb : Ra;
                f32x4 v[8]; float s1 = 0.f;
#pragma unroll
                for (int j = 0; j < 8; ++j) { const u32x2 w = R.mr[j]; v[j] = (f32x4){__uint_as_float(w.x << 16), __uint_as_float(w.x & 0xffff0000u), __uint_as_float(w.y << 16), __uint_as_float(w.y & 0xffff0000u)}; s1 += (v[j].x * v[j].x + v[j].y * v[j].y) + (v[j].z * v[j].z + v[j].w * v[j].w); }
                const float rs = 1.0f / sqrtf(wave_sum(s1) * (1.0f / DM) + EPS);
                const float* mb = mod + b * 12288; float s2 = 0.f;
#pragma unroll
                for (int j = 0; j < 8; ++j) { const int k = 4 * F.lane + 256 * j; const f32x4 gg = *(const f32x4*)(gpost + k), gt = *(const f32x4*)(mb + 2 * DM + k);
                    v[j] = R.xr[j] + gt * (v[j] * rs * gg); s2 += (v[j].x * v[j].x + v[j].y * v[j].y) + (v[j].z * v[j].z + v[j].w * v[j].w); }
                const float rs2 = 1.0f / sqrtf(wave_sum(s2) * (1.0f / DM) + EPS);
                u32x2* oh = (u32x2*)(H + (size_t)(F.bid * 16 + rl) * DM) + F.lane; LAS u32x2* ol = (LAS u32x2*)(lo + rl * LO_PITCH) + F.lane;
                unsigned* o8 = (unsigned*)(WSP(unsigned char, WS_H2LO) + (size_t)m * DM) + F.lane;
#pragma unroll
                for (int j = 0; j < 8; ++j) { const int k = 4 * F.lane + 256 * j; const f32x4 gg = *(const f32x4*)(gpre + k), sc = *(const f32x4*)(mb + 4 * DM + k), sh = *(const f32x4*)(mb + 3 * DM + k);
                    const f32x4 h = v[j] * rs2 * gg * (1.0f + sc) + sh;
                    const unsigned h0 = f2bf(h.x), h1 = f2bf(h.y), h2 = f2bf(h.z), h3 = f2bf(h.w);
                    { const u32x2 hv = (u32x2){h0 | (h1 << 16), h2 | (h3 << 16)}; asm volatile("global_store_dwordx2 %0, %1, off" : : "v"(oh + 64 * j), "v"(hv) : "memory"); }
                    { const unsigned h8 = pk4_fp8(h.x, h.y, h.z, h.w); asm volatile("global_store_dword %0, %1, off" : : "v"(o8 + 64 * j), "v"(h8) : "memory"); }
                    ol[64 * j] = (u32x2){pk2(h.x - bf2f(h0), h.y - bf2f(h1)), pk2(h.z - bf2f(h2), h.w - bf2f(h3))}; }
            }
            VM_WAIT(); __syncthreads();
            { f32x4 acc[4];
#pragma unroll
              for (int cb = 0; cb < 4; ++cb) acc[cb] = (f32x4){0.f, 0.f, 0.f, 0.f};
              const size_t aoff = (size_t)(F.bid * 16 + r16) * DM + 256 * F.wave + 8 * kq, boff = (size_t)r16 * DM + 256 * F.wave + 8 * kq;
              const LAS unsigned char* lrow = lo + r16 * LO_PITCH + (256 * F.wave + 8 * kq) * 2;
#pragma unroll 4
              for (int ks = 0; ks < 8; ++ks) {
                  const bf16x8 ah = *(const bf16x8*)(H + aoff + 32 * ks); const bf16x8 al = *(const LAS bf16x8*)(lrow + 64 * ks);
#pragma unroll
                  for (int cb = 0; cb < 4; ++cb) { const bf16x8 bh = *(const bf16x8*)(WH + boff + (size_t)cb * 16 * DM + 32 * ks), bl = *(const bf16x8*)(WL + boff + (size_t)cb * 16 * DM + 32 * ks);
                      acc[cb] = __builtin_amdgcn_mfma_f32_16x16x32_bf16(ah, bh, acc[cb], 0, 0, 0);
                      acc[cb] = __builtin_amdgcn_mfma_f32_16x16x32_bf16(al, bh, acc[cb], 0, 0, 0);
                      acc[cb] = __builtin_amdgcn_mfma_f32_16x16x32_bf16(ah, bl, acc[cb], 0, 0, 0); } }
              if (pass == 0) { p9_load(Ra, MX, x, m0 + 16 + 2 * F.wave, F.lane); p9_load(Rb, MX, x, m0 + 16 + 2 * F.wave + 1, F.lane); }
#pragma unroll
              for (int cb = 0; cb < 4; ++cb)
#pragma unroll
                  for (int rg = 0; rg < 4; ++rg) red[(F.wave * 16 + 4 * kq + rg) * 64 + cb * 16 + r16] = acc[cb][rg]; }
            __syncthreads();
            { const int row = F.tid >> 5, c2 = (F.tid & 31) * 2; float s0 = 0.f, s1 = 0.f;
#pragma unroll
              for (int w = 0; w < 8; ++w) { const f32x2 t = *(const LAS f32x2*)(red + (w * 16 + row) * 64 + c2); s0 += t.x; s1 += t.y; }
              *(LAS f32x2*)(lg + row * 64 + c2) = (f32x2){s0, s1}; }
            __syncthreads();
#pragma unroll
            for (int q2 = 0; q2 < 2; ++q2) {
                const int q = 2 * pass + q2;
                const int r = F.wave * 2 + q2, e = F.lane; const float score = 1.0f / (1.0f + expf(-lg[r * 64 + e])); const float sel = score + rb_e;
                float m1 = sel;
#pragma unroll
                for (int o = 1; o < 8; o <<= 1) m1 = fmaxf(m1, __shfl_xor(m1, o));
                int i1 = (sel == m1) ? e : 64;
#pragma unroll
                for (int o = 1; o < 8; o <<= 1) { const int t2 = __shfl_xor(i1, o); i1 = t2 < i1 ? t2 : i1; }
                float m2 = (e == i1) ? -3.0e38f : sel;
#pragma unroll
                for (int o = 1; o < 8; o <<= 1) m2 = fmaxf(m2, __shfl_xor(m2, o));
                const float gs = m1 + m2; const int g = e >> 3; int grank = 0;
#pragma unroll
                for (int g2 = 0; g2 < 8; ++g2) { const float o = __uint_as_float((unsigned)__builtin_amdgcn_readlane((int)__float_as_uint(gs), g2 * 8)); grank += (o > gs || (o == gs && g2 < g)) ? 1 : 0; }
                const float v = (grank < TOPG) ? sel : -INFINITY; int rank = 0;
#pragma unroll
                for (int e2 = 0; e2 < 64; ++e2) { const float o = __uint_as_float((unsigned)__builtin_amdgcn_readlane((int)__float_as_uint(v), e2)); rank += (o > v || (o == v && e2 < e)) ? 1 : 0; }
                const bool chosen = rank < TOPK; const float wsum = wave_sum(chosen ? score : 0.f);
                const unsigned long long bal = __ballot(chosen); const int kidx = __popcll(bal & ((1ull << e) - 1ull));
                sel_f[q] = chosen; sel_e[q] = e; sel_k[q] = kidx; sel_w[q] = score / wsum * 2.5f; sel_pos[q] = chosen ? __hip_atomic_fetch_add(&lcnt[e], 1, __ATOMIC_RELAXED, __HIP_MEMORY_SCOPE_WORKGROUP) : 0;
            }
            __syncthreads();
        }
        if (F.tid < 64) { const int n = lcnt[F.tid]; lbase[F.tid] = n ? (int)atomicAdd(&gcnt[F.tid], (unsigned)n) : 0; }
        __syncthreads();
#pragma unroll
        for (int q = 0; q < 4; ++q) if (sel_f[q]) { const int tok = m0 + 16 * (q >> 1) + F.wave * 2 + (q & 1), e = sel_e[q], pos = lbase[e] + sel_pos[q];
            rowtok[(size_t)e * NTOK + pos] = tok; tinfo[tok * 8 + sel_k[q]] = ((unsigned)e << 16) | (unsigned)pos; tw[tok * 8 + sel_k[q]] = sel_w[q]; }
        __syncthreads();
    }
}
__device__ __forceinline__ f32x4 dec4_fp8(unsigned q) { const f32x2 lo = __builtin_amdgcn_cvt_pk_f32_fp8((int)q, false), hi = __builtin_amdgcn_cvt_pk_f32_fp8((int)q, true); return (f32x4){lo.x, lo.y, hi.x, hi.y}; }
__device__ __forceinline__ void p11_out(Frame& F, const MoeTab& T) {
    const int gw = F.bid * NWAVES + F.wave, NGW = F.G * NWAVES;
    const float* gpost = INF(8); const float* mod = WSP(float, WS_MOD); const unsigned char* Y = WSP(unsigned char, WS_Y); const unsigned char* YS = WSP(unsigned char, WS_YS);
    const unsigned* tinfo = WSP(unsigned, WS_TOKINFO); const float* tw = (const float*)(tinfo + NTOK * 8);
    for (int m = gw; m < NTOK; m += NGW) {
        const int b = m / SEQ;
        int ln = F.lane; asm volatile("" : "+v"(ln));
        const unsigned inf_l = tinfo[m * 8 + (ln & 7)]; const float w_l = tw[m * 8 + (ln & 7)];
        unsigned yv[TOPK][8]; float wk[TOPK];
#pragma unroll
        for (int k = 0; k < TOPK; ++k) { const unsigned inf = (unsigned)__builtin_amdgcn_readlane((int)inf_l, k); wk[k] = __uint_as_float((unsigned)__builtin_amdgcn_readlane((int)__float_as_uint(w_l), k)) * (1.0f / Y_SCALE);
            const int e = inf >> 16, pos = inf & 0xffff; const size_t slot = (size_t)T.mtoff[e] * 256 + pos; const unsigned* yr = (const unsigned*)(Y + slot * DM) + ln;
#pragma unroll
            for (int j = 0; j < 8; ++j) yv[k][j] = yr[64 * j]; }
        unsigned sv[8]; f32x4 xv[8]; u32x2 mv[8];
        { const unsigned* ys = (const unsigned*)(YS + (size_t)m * DM) + ln; const f32x4* xi = (const f32x4*)(INF(0) + (size_t)m * DM) + ln; const u32x2* mr = (const u32x2*)(WSP(bf16, WS_MIXED) + (size_t)m * DM) + ln;
#pragma unroll
          for (int j = 0; j < 8; ++j) { sv[j] = ys[64 * j]; xv[j] = xi[64 * j]; mv[j] = mr[64 * j]; } }
        { float s1 = 0.f;
#define MX_UNPACK(w) ((f32x4){__uint_as_float((w).x << 16), __uint_as_float((w).x & 0xffff0000u), __uint_as_float((w).y << 16), __uint_as_float((w).y & 0xffff0000u)})
#pragma unroll
          for (int j = 0; j < 8; ++j) { const f32x4 mx = MX_UNPACK(mv[j]); s1 += (mx.x * mx.x + mx.y * mx.y) + (mx.z * mx.z + mx.w * mx.w); }
          const float rs1 = 1.0f / sqrtf(wave_sum(s1) * (1.0f / DM) + EPS); const float* gp1 = INF(6); const float* gt1 = mod + b * 12288 + 2 * DM;
#pragma unroll
          for (int j = 0; j < 8; ++j) { const int k = 4 * ln + 256 * j; const f32x4 gg = *(const f32x4*)(gp1 + k), gt = *(const f32x4*)(gt1 + k); const f32x4 mx = MX_UNPACK(mv[j]); xv[j] = xv[j] + gt * (mx * rs1 * gg); } }
#undef MX_UNPACK
        f32x4 acc[8];
#pragma unroll
        for (int j = 0; j < 8; ++j) acc[j] = dec4_fp8(sv[j]) * (1.0f / Y_SCALE);
#pragma unroll
        for (int k = 0; k < TOPK; ++k)
#pragma unroll
            for (int j = 0; j < 8; ++j) acc[j] += wk[k] * dec4_fp8(yv[k][j]);
        float s2 = 0.f;
#pragma unroll
        for (int j = 0; j < 8; ++j) s2 += (acc[j].x * acc[j].x + acc[j].y * acc[j].y) + (acc[j].z * acc[j].z + acc[j].w * acc[j].w);
        const float rs = 1.0f / sqrtf(wave_sum(s2) * (1.0f / DM) + EPS);
        const float* gt2 = mod + b * 12288 + 5 * DM; f32x4* xo = (f32x4*)(F.out + (size_t)m * DM) + ln;
        __builtin_amdgcn_sched_barrier(0);
#pragma unroll
        for (int hh = 0; hh < 2; ++hh) { f32x4 gg2[4], gtv[4];
#pragma unroll
            for (int j = 0; j < 4; ++j) { const int k = 4 * ln + 256 * (4 * hh + j); gg2[j] = *(const f32x4*)(gpost + k); gtv[j] = *(const f32x4*)(gt2 + k); }
#pragma unroll
            for (int j = 0; j < 4; ++j) xo[64 * (4 * hh + j)] = xv[4 * hh + j] + gtv[j] * (acc[4 * hh + j] * rs * gg2[j]); }
    }
}

constexpr int NPHASE = 13;
__global__ void __launch_bounds__(NTHR, 2) mk_fwd(Args args) {
    extern __shared__ __attribute__((aligned(16))) unsigned char lds_raw[];
    Frame F; F.lds = (LAS unsigned char*)lds_raw; F.ws = args.ws; F.in = args.in; F.out = args.out;
    F.tid = threadIdx.x; F.lane = F.tid & 63; F.wave = __builtin_amdgcn_readfirstlane(F.tid >> 6); F.G = gridDim.x; F.bid = blockIdx.x; F.vcu = (F.G % 8 == 0) ? (F.bid % 8) * (F.G / 8) + F.bid / 8 : F.bid;
    volatile LAS unsigned* MISC = (volatile LAS unsigned*)(F.lds + MISC_OFF);
    if (F.tid < 64) MISC[F.tid] = 0u;
    __syncthreads();
    const int lo = args.ph_lo, hi = args.ph_hi;
    XcdBarrier bar; bar.bar = WSP(unsigned, WS_CTL) + CW_BAR; bar.x = 0; bar.st = MISC + 8;
    if (hi - lo > 1) bar = xcd_barrier_post(WSP(unsigned, WS_CTL) + CW_BAR, MISC + 8);
#ifndef REP_PHASE
#define REP_PHASE -1
#endif
#define IN(k) (lo <= (k) && (k) < hi)
#ifndef WAITPROBE
#define WAITPROBE -1
#endif
    unsigned long long wp_acc = 0ull;
#define SEAM(k) do { if (IN(k) && IN((k) + 1)) { unsigned long long wp_t0 = 0ull; if (WAITPROBE >= 0) wp_t0 = __builtin_amdgcn_s_memrealtime(); xcd_barrier(bar); \
        if (WAITPROBE == (k) || WAITPROBE == 99) wp_acc += __builtin_amdgcn_s_memrealtime() - wp_t0; } } while (0)
    MoeTab MT; MT.mtoff = (LAS int*)(F.lds + MISC_OFF + 256); MT.cnt = MT.mtoff + 72;

#define RUN(id, ...) do { __VA_ARGS__; if (REP_PHASE == (id)) { __syncthreads(); __VA_ARGS__; __syncthreads(); } } while (0)
    if (IN(0)) { RUN(0, p0_mod(F); p0_small(F); p0_transposes<false>(F)); } SEAM(0);
    if (IN(1)) { RUN(1, p1_h1(F)); } SEAM(1);
    if (IN(2)) { GridSched S; S.init(WSP(bf16, WS_H), DM, WSP(bf16, WS_WIN), DM, NTOK, 2048, F.G, F.bid);
        GridSched S8; S8.init(WSP(bf16, WS_H2LO), DM / 2, (const bf16*)(WSP(unsigned char, WS_H2LO) + 16 * MiB), DM / 2, NTOK, 4096, F.G, F.bid);
        EpiG1 E{WSP(bf16, WS_QL), WSP(bf16, WS_KVL), WSP(bf16, WS_U), WSP(bf16, WS_SGM), WSP(bf16, WS_SGS), WSP(float, WS_RSS), 0};
        EpiG1 E8{WSP(bf16, WS_QL), WSP(bf16, WS_KVL), WSP(bf16, WS_U), WSP(bf16, WS_SGM), WSP(bf16, WS_SGS), WSP(float, WS_RSS), 8};
        if (F.vcu & 1) { p0_transposes<true>(F); __syncthreads(); }
        RUN(2, gemm_run<false>(F, S, E)); __syncthreads();
        gemm_run<false, false, E8_GU_W, E8_ONE>(F, S8, E8);
        if (!(F.vcu & 1)) { __syncthreads(); p0_transposes<true>(F); } } SEAM(2);
    if (IN(3)) { P3Sched S{WSP(bf16, WS_QL), WSP(bf16, WS_KVL), WSP(bf16, WS_WUQ), WSP(bf16, WS_WUKV), 512, 512, F.G, F.vcu};
        EpiP3 E{WSP(bf16, WS_Q), WSP(bf16, WS_KN), WSP(bf16, WS_VT), WSP(float, WS_RSS), WSP(f32x2, WS_ROPE)};
        RUN(30, gemm_run<false>(F, S, E)); __syncthreads();
        RUN(31, p3_kpe_mfma(F)); __syncthreads();
        RUN(32, s5_fused(F)); } SEAM(3);
    if (IN(4)) { RUN(40, att3::attn_phase(F)); __syncthreads();
        GluSched S{WSP(bf16, WS_YG), WSP(bf16, WS_WGLU), 1024, 1024, F.G, F.vcu};
        EpiMix E{WSP(bf16, WS_M1), WSP(bf16, WS_S5O), WSP(bf16, WS_SGM), WSP(bf16, WS_SGS), WSP(bf16, WS_YG)};
        gemm_run<false, true>(F, S, E); } SEAM(4);
    if (IN(5)) { PairSched S{WSP(bf16, WS_AO), WSP(bf16, WS_WBRM), WSP(bf16, WS_S5O), WSP(bf16, WS_WBRS), 1024, 1024, F.G, F.vcu};
        EpiMix E{WSP(bf16, WS_M1), WSP(bf16, WS_S5O), WSP(bf16, WS_SGM), WSP(bf16, WS_SGS), WSP(bf16, WS_YG)};
        RUN(5, gemm_run<false>(F, S, E)); } SEAM(6);
    if (IN(7)) { GridSched S; S.init(WSP(bf16, WS_M1), DM, WSP(bf16, WS_WOUT), DM, NTOK, DM, F.G, F.bid);
        EpiBf16Plain E{WSP(bf16, WS_MIXED), DM}; RUN(7, gemm_run<false>(F, S, E)); } SEAM(7);
    if (IN(9)) { p9_route_lds(F); } SEAM(9);
    if (IN(10)) { moe_build_tab(F, MT);
        MoeSched<4, false> S{MT, WSP(bf16, WS_H2LO), nullptr, WSP(bf16, WS_WGU), WSP(int, WS_ROWTOK), DM / 2, DM / 2, F.G, F.vcu};
        EpiGU E{WSP(bf16, WS_ACT), WSP(bf16, WS_ACTS)}; RUN(10, gemm_run<true, true, E8_GU_W, E8_ONE>(F, S, E)); } SEAM(10);
    if (IN(11)) { moe_build_tab(F, MT);
        MoeSched<8, true> S{MT, WSP(bf16, WS_ACT), WSP(bf16, WS_ACTS), WSP(bf16, WS_WD), nullptr, DE / 2, DE / 2, F.G, F.vcu};
        EpiDown E{WSP(bf16, WS_Y), WSP(bf16, WS_YS)}; RUN(11, gemm_run<false, true, E8_DN_W, E8_ACT>(F, S, E)); } SEAM(11);
    if (IN(12)) { moe_build_tab(F, MT); p11_out(F, MT); }
    if (REP_PHASE == 99 && hi - lo > 1) { for (int q = 0; q < 10; ++q) xcd_barrier(bar); }
    if (WAITPROBE >= 0 && hi - lo > 1) {
        unsigned* wp = WSP(unsigned, WS_CTL) + 12288;
        if (F.tid == 0) atomicAdd(wp, (unsigned)wp_acc);
        xcd_barrier(bar);
        if (F.bid == 0 && F.tid == 0) { const unsigned sum = __hip_atomic_load(wp, __ATOMIC_RELAXED, __HIP_MEMORY_SCOPE_AGENT); const unsigned long long dl = (unsigned long long)sum * 16ull / (unsigned)F.G;
            const unsigned long long t0 = __builtin_amdgcn_s_memrealtime(); while (__builtin_amdgcn_s_memrealtime() - t0 < dl) __builtin_amdgcn_s_sleep(8); }
    }
}

extern "C" void kernel_launch(void* const* d_in, const int* in_sizes, int n_in, void* d_out, int out_size, void* d_ws, size_t ws_size, hipStream_t stream) {
    static int grid = 0;
    if (!grid) {
        if (n_in != 35 || out_size != NTOK * DM || ws_size < WS_END) { fprintf(stderr, "kernel_launch: unexpected problem (n_in %d out %d ws %zu, need %zu)\n", n_in, out_size, ws_size, (size_t)WS_END); }
        int dev = 0, cus = 0, per_cu = 0;
        (void)hipGetDevice(&dev); (void)hipDeviceGetAttribute(&cus, hipDeviceAttributeMultiprocessorCount, dev);
        (void)hipFuncSetAttribute((const void*)mk_fwd, hipFuncAttributeMaxDynamicSharedMemorySize, LDS_BYTES);
        (void)hipOccupancyMaxActiveBlocksPerMultiprocessor(&per_cu, (const void*)mk_fwd, NTHR, LDS_BYTES);
        if (per_cu < 1) fprintf(stderr, "kernel_launch: occupancy query says %d blocks per CU\n", per_cu);
        grid = cus > 0 ? cus : 256;
    }
    (void)hipMemsetAsync((char*)d_ws + WS_CTL, 0, CTL_ZERO_BYTES, stream);
    Args a{};
    for (int i = 0; i < 35; ++i) a.in[i] = d_in[i];
    a.out = (float*)d_out; a.ws = (unsigned char*)d_ws;
#if MK_ONE_LAUNCH
    a.ph_lo = 0; a.ph_hi = NPHASE;
    hipLaunchKernelGGL(mk_fwd, dim3(grid), dim3(NTHR), LDS_BYTES, stream, a);
#else
    for (int p = 0; p < NPHASE; ++p) { a.ph_lo = p; a.ph_hi = p + 1; hipLaunchKernelGGL(mk_fwd, dim3(grid), dim3(NTHR), LDS_BYTES, stream, a); }
#endif
}
```

```cpp
#include <hip/hip_runtime.h>
#include <cstdio>
#include <cstdint>

#ifndef MK_ONE_LAUNCH
#define MK_ONE_LAUNCH 1
#endif

#define GAS __attribute__((address_space(1)))
#define LAS __attribute__((address_space(3)))
typedef unsigned short bf16;
typedef float f32x4 __attribute__((ext_vector_type(4)));
typedef float f32x2 __attribute__((ext_vector_type(2)));
typedef unsigned u32x4 __attribute__((ext_vector_type(4)));
typedef unsigned u32x2 __attribute__((ext_vector_type(2)));
typedef short bf16x8 __attribute__((ext_vector_type(8)));

constexpr int NB = 4, SEQ = 2048, DM = 2048, NTOK = NB * SEQ;
constexpr int NH = 8, DNOPE = 128, DROPE = 64, DQK = 192, DV = 128, QLORA = 512, KVLORA = 512;
constexpr int S5CH = 1024, S5G = 64, S5P = 64, S5GC = 16;
constexpr int NE = 64, TOPK = 6, NEG = 8, TOPG = 4, DE = 512;
constexpr int INC = 6208, N1 = 6144;
constexpr float EPS = 1e-6f;
constexpr float QSCALE = 0.07216878364870322f * 1.4426950408889634f;
constexpr int NWAVES = 8, NTHR = 512;
constexpr int SCH = 64, NCHUNK = SEQ / SCH;

constexpr size_t MiB = 1u << 20;
constexpr size_t WS_CTL = 0, CTL_ZERO_BYTES = 65536;
constexpr size_t WS_MOD = 1 * MiB;
constexpr size_t WS_S5P = 2 * MiB;
constexpr size_t WS_ROPE = 3 * MiB;
constexpr size_t WS_TILEC = 5 * MiB;
constexpr size_t WS_S5E = 6 * MiB;
constexpr size_t WS_RSS = 10 * MiB;
constexpr size_t WS_ROWTOK = 11 * MiB;
constexpr size_t WS_TOKINFO = 13 * MiB;
constexpr size_t WS_S5BF = 14 * MiB;
constexpr size_t WS_WIN = 16 * MiB, WS_WPE = 40 * MiB, WS_WUQ = 41 * MiB, WS_WUKV = 43 * MiB, WS_WGLU = 45 * MiB, WS_WBRM = 47 * MiB, WS_WBRS = 51 * MiB,
                 WS_WOUT = 55 * MiB, WS_WR = 63 * MiB, WS_WGU = 64 * MiB, WS_WD = 324 * MiB;
constexpr size_t WS_H = 454 * MiB, WS_ACT = 486 * MiB, WS_ACTS = 550 * MiB, WS_YS = 558 * MiB, WS_BIG = 590 * MiB;
constexpr size_t WS_QL = WS_BIG, WS_KVL = WS_BIG + 8 * MiB, WS_U = WS_BIG + 16 * MiB, WS_SGM = WS_BIG + 32 * MiB, WS_SGS = WS_BIG + 64 * MiB, WS_Q = WS_BIG + 96 * MiB,
                 WS_KN = WS_BIG + 120 * MiB, WS_KPE = WS_BIG + 136 * MiB, WS_VT = WS_BIG + 137 * MiB, WS_AO = WS_BIG + 153 * MiB, WS_YG = WS_BIG + 169 * MiB,
                 WS_S5O = WS_BIG + 185 * MiB, WS_M1 = WS_BIG + 201 * MiB, WS_MIXED = WS_BIG + 233 * MiB, WS_H2LO = WS_BIG + 297 * MiB;
constexpr size_t WS_Y = WS_BIG;
constexpr size_t WS_END = WS_BIG + 329 * MiB;
static_assert(WS_Y + 256 * MiB <= WS_H2LO, "Y overlay must not reach H2LO... (H2LO is dead by P10 anyway)");

constexpr int CW_TMO = 0, CW_BAR = 4096, CW_CNT = 8192;

constexpr int LDS_BYTES = 147456;
constexpr int MISC_OFF = 131072 + 8192;

__device__ __forceinline__ float bf2f(unsigned h) { return __uint_as_float(h << 16); }
__device__ __forceinline__ unsigned f2bf(float f) { unsigned u = __float_as_uint(f); return (u + 0x7fffu + ((u >> 16) & 1u)) >> 16; }
__device__ __forceinline__ unsigned pk2(float lo, float hi) { unsigned r; asm("v_cvt_pk_bf16_f32 %0, %1, %2" : "=v"(r) : "v"(lo), "v"(hi)); return r; }
template <int CTRL> __device__ __forceinline__ float dppf(float v) { return __int_as_float(__builtin_amdgcn_mov_dpp(__float_as_int(v), CTRL, 0xF, 0xF, true)); }
template <int CTRL> __device__ __forceinline__ int dppi(int v) { return __builtin_amdgcn_mov_dpp(v, CTRL, 0xF, 0xF, true); }
constexpr int DPP_X1 = 0xB1, DPP_X2 = 0x4E, DPP_HM = 0x141, DPP_RM = 0x140;
__device__ __forceinline__ float wave_sum(float v) {
    v += dppf<DPP_X1>(v); v += dppf<DPP_X2>(v); v += dppf<DPP_HM>(v); v += dppf<DPP_RM>(v);
    v += __shfl_xor(v, 16); v += __shfl_xor(v, 32);
    return v;
}
__device__ __forceinline__ float sigm(float x) { return __builtin_amdgcn_rcpf(1.0f + __builtin_amdgcn_exp2f(-1.4426950408889634f * x)); }
__device__ __forceinline__ void unpack8(const u32x4 w, float (&f)[8]) {
    f[0] = __uint_as_float(w.x << 16); f[1] = __uint_as_float(w.x & 0xffff0000u); f[2] = __uint_as_float(w.y << 16); f[3] = __uint_as_float(w.y & 0xffff0000u);
    f[4] = __uint_as_float(w.z << 16); f[5] = __uint_as_float(w.z & 0xffff0000u); f[6] = __uint_as_float(w.w << 16); f[7] = __uint_as_float(w.w & 0xffff0000u);
}
__device__ __forceinline__ u32x4 pack8(const float (&f)[8]) { u32x4 w; w.x = pk2(f[0], f[1]); w.y = pk2(f[2], f[3]); w.z = pk2(f[4], f[5]); w.w = pk2(f[6], f[7]); return w; }
__device__ __forceinline__ float clamp448(float x) { return fminf(fmaxf(x, -448.f), 448.f); }
__device__ __forceinline__ unsigned pk4_fp8(float a, float b, float c, float d) {
    int p = 0; p = __builtin_amdgcn_cvt_pk_fp8_f32(clamp448(a), clamp448(b), p, false); p = __builtin_amdgcn_cvt_pk_fp8_f32(clamp448(c), clamp448(d), p, true); return (unsigned)p; }
constexpr float GU_WSCALE = 64.f, DN_WSCALE = 32.f, ACT_SCALE = 8.f, Y_SCALE = 16.f;
constexpr int E8_GU_W = 127 - 6, E8_DN_W = 127 - 5, E8_ACT = 127 - 3, E8_ONE = 127;
#define LDS_WAIT() asm volatile("s_waitcnt lgkmcnt(0)" ::: "memory")
#define VM_WAIT() asm volatile("s_waitcnt vmcnt(0)" ::: "memory")

#define XB_TMO      128
#define XB_XCNT(j)  (256  + 64 * (j))
#define XB_XSUB(j)  (1280 + 64 * (j))
#define XB_XGEN(j)  (2304 + 64 * (j))
#define XB_TOP      3328
#define XB_TOPGEN   3392
#define XCD_BAR_WORDS 3456
#define XB_SPIN_CAP (1u << 18)
__device__ __forceinline__ unsigned xb_ld(unsigned* p)              { return __hip_atomic_load(p, __ATOMIC_RELAXED, __HIP_MEMORY_SCOPE_AGENT); }
__device__ __forceinline__ unsigned xb_add(unsigned* p, unsigned v) { return __hip_atomic_fetch_add(p, v, __ATOMIC_RELAXED, __HIP_MEMORY_SCOPE_AGENT); }
__device__ __forceinline__ unsigned xb_xcc_id() { return (unsigned)__builtin_amdgcn_s_getreg((3 << 11) | 20) & 0xFu; }
#define XB_SPIN(cond, bar) do { unsigned _sp = 0; while (cond) { __builtin_amdgcn_s_sleep(1); \
    if ((++_sp & 255u) == 0u) { if (xb_ld(&(bar)[XB_TMO])) break; if (_sp > XB_SPIN_CAP) { atomicAdd(&(bar)[XB_TMO], 1u); break; } } } } while (0)
struct XcdBarrier { unsigned* bar; unsigned x; volatile LAS unsigned* st; };
__device__ __forceinline__ XcdBarrier xcd_barrier_post(unsigned* bar, volatile LAS unsigned* st) {
    XcdBarrier b; b.bar = bar; b.x = xb_xcc_id(); b.st = st;
    if (threadIdx.x == 0) (void)xb_add(&bar[XB_XCNT(b.x)], 1u);
    return b;
}
__device__ __forceinline__ void xcd_barrier_complete(unsigned* bar, unsigned x, unsigned& nloc, unsigned& nx) {
    const unsigned G = gridDim.x * gridDim.y * gridDim.z;
    unsigned sum, cnt, mine, sp = 0u;
    for (;;) {
        sum = 0u; cnt = 0u; mine = 0u;
#pragma unroll
        for (unsigned j = 0; j < 16; ++j) { const unsigned c = xb_ld(&bar[XB_XCNT(j)]); sum += c; cnt += (c > 0u) ? 1u : 0u; mine = (j == x) ? c : mine; }
        if (sum == G) break;
        __builtin_amdgcn_s_sleep(1);
        if ((++sp & 255u) == 0u) { if (xb_ld(&bar[XB_TMO])) break; if (sp > XB_SPIN_CAP) { atomicAdd(&bar[XB_TMO], 1u); break; } }
    }
    nloc = mine > 0u ? mine : 1u; nx = cnt > 0u ? cnt : 1u;
}
__device__ __forceinline__ void xcd_barrier(const XcdBarrier& b) {
    asm volatile("s_waitcnt vmcnt(0)" ::: "memory");
    __syncthreads();
    if (threadIdx.x == 0) {
        unsigned* bar = b.bar;
        __builtin_amdgcn_s_waitcnt(0);
        unsigned nloc = b.st[0], nx = b.st[1];
        if (nloc == 0u) { xcd_barrier_complete(bar, b.x, nloc, nx); b.st[0] = nloc; b.st[1] = nx; }
        const unsigned old = xb_add(&bar[XB_XSUB(b.x)], 1u);
        const unsigned gen = old / nloc;
        if (old + 1u == (gen + 1u) * nloc) {
            __builtin_amdgcn_fence(__ATOMIC_RELEASE, "agent");
            asm volatile("s_waitcnt vmcnt(0)" ::: "memory");
            const unsigned og = xb_add(&bar[XB_TOP], 1u);
            const unsigned tg = og / nx;
            if (og + 1u == (tg + 1u) * nx) xb_add(&bar[XB_TOPGEN], 1u);
            else XB_SPIN(xb_ld(&bar[XB_TOPGEN]) == tg, bar);
            __builtin_amdgcn_fence(__ATOMIC_ACQUIRE, "agent");
            xb_add(&bar[XB_XGEN(b.x)], 1u);
            asm volatile("s_waitcnt vmcnt(0)" ::: "memory");
        } else {
            XB_SPIN(xb_ld(&bar[XB_XGEN(b.x)]) == gen, bar);
            __builtin_amdgcn_fence(__ATOMIC_ACQUIRE, "agent");
            asm volatile("s_waitcnt vmcnt(0)" ::: "memory");
        }
    }
    __syncthreads();
}

struct Args { const void* in[35]; float* out; unsigned char* ws; int ph_lo, ph_hi; };
struct Frame {
    LAS unsigned char* lds;
    unsigned char* ws;
    const void* const* in;
    float* out;
    int tid, lane, wave, G, bid, vcu;
};
#define INF(k) ((const float*)F.in[k])
#define WSP(T, off) ((T*)(F.ws + (off)))

struct TSeg { const float* src; int ldn; int K; bf16* dst; const float* kscale; int perm; int kt; int fp8; float wscale; };
__device__ __forceinline__ void tt_load(const TSeg& s, f32x4 (&v)[16], int lane) {
    const int k0 = s.kt * 64;
#pragma unroll
    for (int j = 0; j < 16; ++j) { const int k = 4 * j + (lane >> 4), n4 = lane & 15; v[j] = __builtin_nontemporal_load((const f32x4*)(s.src + (size_t)(k0 + k) * s.ldn + 4 * n4)); }
}
struct TPend { unsigned char* d; int K; int have; };
__device__ __forceinline__ void tt_flush(const TPend& pp, const u32x2 (&pk)[8], int lane) {
    unsigned char* d8 = pp.d + (size_t)(lane >> 3) * pp.K + 8 * (lane & 7); const size_t st = (size_t)8 * pp.K;
#pragma unroll
    for (int j = 0; j < 8; ++j) asm volatile("global_store_dwordx2 %0, %1, off nt" : : "v"(d8 + j * st), "v"(pk[j]) : "memory");
}
template <bool EXPERT>
__device__ __forceinline__ void tt_finish(const TSeg& s, const f32x4 (&v)[16], LAS float* scr, int lane, TPend& pp, u32x2 (&pkh)[8]) {
    const int k0 = s.kt * 64;
    const float* kscale = EXPERT ? nullptr : s.kscale; const int perm = EXPERT ? 0 : s.perm; const int isfp8 = EXPERT ? 1 : s.fp8;
    float ksv[16];
#pragma unroll
    for (int j = 0; j < 16; ++j) ksv[j] = 1.0f;
    if (!EXPERT && kscale) {
#pragma unroll
        for (int j = 0; j < 16; ++j) ksv[j] = kscale[k0 + 4 * j + (lane >> 4)]; }
#pragma unroll
    for (int j = 0; j < 16; ++j) { const int k = 4 * j + (lane >> 4), n4 = lane & 15;
        f32x4 w = v[j]; if (!EXPERT) w = w * ksv[j];
        *(LAS f32x4*)(scr + k * 64 + ((n4 ^ ((k >> 3) & 7)) << 2)) = w; }
    LDS_WAIT();
    if constexpr (EXPERT) { if (pp.have) tt_flush(pp, pkh, lane); }
    const int c = lane & 7;
#pragma unroll
    for (int j = 0; j < 8; ++j) {
        const int nn = (lane >> 3) + 8 * j;
        int ns = nn; if (perm) { const int a = nn >> 3, b = nn & 7; ns = (b < 4) ? (4 * a + b) : (32 + 4 * a + (b - 4)); }
        float f[8];
#pragma unroll
        for (int i = 0; i < 8; ++i) { const int k = 8 * c + i; f[i] = scr[k * 64 + ((((ns >> 2) ^ c) & 15) << 2) + (ns & 3)]; }
        if (isfp8) { const float w = s.wscale;
            const u32x2 pk = (u32x2){pk4_fp8(f[0] * w, f[1] * w, f[2] * w, f[3] * w), pk4_fp8(f[4] * w, f[5] * w, f[6] * w, f[7] * w)};
            if constexpr (EXPERT) pkh[j] = pk;
            else { unsigned char* d8 = (unsigned char*)s.dst + (size_t)nn * s.K + k0 + 8 * c; asm volatile("global_store_dwordx2 %0, %1, off nt" : : "v"(d8), "v"(pk) : "memory"); } }
        else { const u32x4 pk = pack8(f); bf16* d = s.dst + (size_t)nn * s.K + k0 + 8 * c;
            asm volatile("global_store_dwordx4 %0, %1, off nt\n\ts_nop 1" : : "v"(d), "v"(pk) : "memory"); }
    }
    if constexpr (EXPERT) { pp.d = (unsigned char*)s.dst + k0; pp.K = s.K; pp.have = 1; }
    LDS_WAIT();
}
constexpr int T_IN_A = 16 * 32, T_IN_B = 80 * 32, T_PE = 0, T_UQ = 24 * 8, T_UK = 16 * 8, T_UV = 16 * 8, T_GLU = 16 * 16, T_BRM = 32 * 16, T_BRS = 32 * 16, T_OUT = 32 * 32,
              T_GU1 = 16 * 32, T_GU = 65 * T_GU1, T_D1 = 32 * 8, T_D = 65 * T_D1;
constexpr int ODD_SHARE_PM = 565;
constexpr int T_TOTAL = T_IN_A + T_IN_B + T_PE + T_UQ + T_UK + T_UV + T_GLU + T_BRM + T_BRS + T_OUT + T_GU + T_D;
__device__ __forceinline__ void tile_desc(Frame& F, int it, TSeg& s) {
    int r = it; s.kscale = nullptr; s.perm = 0; s.fp8 = 0; s.wscale = 1.f; int kt;
    if (r < T_GU) {
        const int e = r / T_GU1, q = r % T_GU1, j16 = q & 15; kt = q >> 4;
        const int isup = j16 >> 3, pn = (j16 & 7) >> 1, c64 = j16 & 1, nt = pn * 4 + isup * 2 + c64;
        const float* srcm = (e < NE) ? (isup ? INF(30) : INF(29)) + (size_t)e * DM * DE : (isup ? INF(33) : INF(32));
        s.src = srcm + 128 * pn + 64 * c64; s.ldn = DE; s.K = DM; s.fp8 = 1; s.wscale = GU_WSCALE; s.dst = (bf16*)(WSP(unsigned char, WS_WGU) + (size_t)e * 1024 * DM + (size_t)(nt * 64) * DM);
    } else if ((r -= T_GU) < T_D) {
        const int e = r / T_D1, q = r % T_D1, nt = q & 31; kt = q >> 5;
        const float* srcm = (e < NE) ? INF(31) + (size_t)e * DE * DM : INF(34);
        s.src = srcm + 64 * nt; s.ldn = DM; s.K = DE; s.fp8 = 1; s.wscale = DN_WSCALE; s.dst = (bf16*)(WSP(unsigned char, WS_WD) + (size_t)e * DM * DE + (size_t)(nt * 64) * DE);
    } else if ((r -= T_D) < T_IN_A) { const int nt = r / 32; kt = r % 32; s.src = INF(9) + 64 * nt; s.ldn = INC; s.K = DM; s.dst = WSP(bf16, WS_WIN) + (size_t)(nt * 64) * DM; }
    else if ((r -= T_IN_A) < T_IN_B) { const int nt = r / 32; kt = r % 32; s.src = INF(9) + 1088 + 64 * nt; s.ldn = INC; s.K = DM;
        if (nt < 16) s.dst = WSP(bf16, WS_WIN) + (size_t)(1024 + nt * 64) * DM;
        else { s.fp8 = 1; s.wscale = GU_WSCALE; s.dst = (bf16*)(WSP(unsigned char, WS_H2LO) + 16 * MiB + (size_t)((nt - 16) * 64) * DM); } }
    else if ((r -= T_IN_B) < T_PE) { kt = r; s.src = INF(9) + 1024; s.ldn = INC; s.K = DM; s.dst = WSP(bf16, WS_WPE); }
    else if ((r -= T_PE) < T_UQ) { const int nt = r / 8; kt = r % 8; s.src = INF(12) + 64 * nt; s.ldn = 1536; s.K = QLORA; s.dst = WSP(bf16, WS_WUQ) + (size_t)(nt * 64) * QLORA; s.kscale = INF(10); s.perm = ((nt % 3) == 2); }
    else if ((r -= T_UQ) < T_UK) { const int nt = r / 8; kt = r % 8; s.src = INF(13) + 64 * nt; s.ldn = 1024; s.K = KVLORA; s.dst = WSP(bf16, WS_WUKV) + (size_t)(nt * 64) * KVLORA; s.kscale = INF(11); }
    else if ((r -= T_UK) < T_UV) { const int nt = r / 8; kt = r % 8; s.src = INF(14) + 64 * nt; s.ldn = 1024; s.K = KVLORA; s.dst = WSP(bf16, WS_WUKV) + (size_t)(1024 + nt * 64) * KVLORA; s.kscale = INF(11); }
    else if ((r -= T_UV) < T_GLU) { const int nt = r / 16; kt = r % 16; s.src = INF(23) + 64 * nt; s.ldn = 1024; s.K = 1024; s.dst = WSP(bf16, WS_WGLU) + (size_t)(nt * 64) * 1024; }
    else if ((r -= T_GLU) < T_BRM) { const int nt = r / 16; kt = r % 16; s.src = INF(24) + 64 * nt; s.ldn = DM; s.K = 1024; s.dst = WSP(bf16, WS_WBRM) + (size_t)(nt * 64) * 1024; }
    else if ((r -= T_BRM) < T_BRS) { const int nt = r / 16; kt = r % 16; s.src = INF(25) + 64 * nt; s.ldn = DM; s.K = 1024; s.dst = WSP(bf16, WS_WBRS) + (size_t)(nt * 64) * 1024; }
    else { r -= T_BRS; const int nt = r / 32; kt = r % 32; s.src = INF(26) + 64 * nt; s.ldn = DM; s.K = DM; s.dst = WSP(bf16, WS_WOUT) + (size_t)(nt * 64) * DM; }
    s.kt = kt;
}
template <bool EXPERT>
__device__ __forceinline__ void p0_transposes(Frame& F) {
    LAS float* scr = (LAS float*)(F.lds + F.wave * 16384);
    int it, end, NGW;
    if constexpr (EXPERT) {
        const int TT = T_GU + T_D, n_odd = F.G / 2, n_even = F.G - n_odd, T_ODD = n_odd ? (int)((long)TT * ODD_SHARE_PM / 1000) : 0;
        if (F.vcu & 1) { it = (F.vcu >> 1) * NWAVES + F.wave; end = T_ODD; NGW = n_odd * NWAVES; } else { it = T_ODD + (F.vcu >> 1) * NWAVES + F.wave; end = TT; NGW = n_even * NWAVES; }
    } else { it = T_GU + T_D + F.vcu * NWAVES + F.wave; end = T_TOTAL; NGW = F.G * NWAVES; }
    TSeg sa, sb; f32x4 va[16], vb[16]; TPend pp{nullptr, 0, 0}; u32x2 pk[8];
    if (it >= end) return;
    tile_desc(F, it, sa); tt_load(sa, va, F.lane);
    while (it + 2 * NGW < end) {
        tile_desc(F, it + NGW, sb); tt_load(sb, vb, F.lane);
        tt_finish<EXPERT>(sa, va, scr, F.lane, pp, pk);
        tile_desc(F, it + 2 * NGW, sa); tt_load(sa, va, F.lane);
        tt_finish<EXPERT>(sb, vb, scr, F.lane, pp, pk);
        it += 2 * NGW;
    }
    if (it + NGW < end) { tile_desc(F, it + NGW, sb); tt_load(sb, vb, F.lane); tt_finish<EXPERT>(sa, va, scr, F.lane, pp, pk); tt_finish<EXPERT>(sb, vb, scr, F.lane, pp, pk); }
    else tt_finish<EXPERT>(sa, va, scr, F.lane, pp, pk);
    if constexpr (EXPERT) tt_flush(pp, pk, F.lane);
}
__device__ __forceinline__ void p0_small(Frame& F) {
    const int gt = F.bid * NTHR + F.tid, NGT = F.G * NTHR;
    { bf16* hi = WSP(bf16, WS_WR); bf16* lo = hi + 64 * DM; const float* wr = INF(27);
      for (int i = gt; i < 64 * DM; i += NGT) { const int e = i >> 11, k = i & 2047; const float w = wr[(size_t)k * 64 + e]; const unsigned h = f2bf(w);
          const int pos = ((((k >> 8) * 8 + ((k >> 5) & 7)) * 4 + (e >> 4)) * 64 + (((k >> 3) & 3) * 16 + (e & 15))) * 8 + (k & 7);
          hi[pos] = (bf16)h; lo[pos] = (bf16)f2bf(w - bf2f(h)); } }
    { bf16* wpe = WSP(bf16, WS_WPE); const float* win = INF(9);
      for (int i = gt; i < 64 * DM; i += NGT) { const int n = i & 63, k = i >> 6; const float w = win[(size_t)k * INC + 1024 + n];
          const int pos = ((((k >> 9) * 16 + ((k >> 5) & 15)) * 4 + (n >> 4)) * 64 + (((k >> 3) & 3) * 16 + (n & 15))) * 8 + (k & 7);
          wpe[pos] = (bf16)f2bf(w); } }
    { f32x2* cs = WSP(f32x2, WS_ROPE); const int* pos = (const int*)F.in[2];
      const float invf = (float)pow(10000.0, -(double)(gt & 31) / 32.0);
      for (int i = gt; i < NTOK * 32; i += NGT) { const int t = i >> 5; const float ang = (float)pos[t] * invf; float sn, cn; sincosf(ang, &sn, &cn);
          cs[i] = (f32x2){cn, sn}; } }
    { int* tc = WSP(int, WS_TILEC); const int* pos = (const int*)F.in[2];
      for (int i = F.bid * NWAVES + F.wave; i < NB * 32; i += F.G * NWAVES) {
          const int c = pos[i * 64 + F.lane] >> 6; int mn = c, mx = c;
#pragma unroll
          for (int o = 1; o < 64; o <<= 1) { const int a = __shfl_xor(mn, o), b2 = __shfl_xor(mx, o); mn = a < mn ? a : mn; mx = b2 > mx ? b2 : mx; }
          if (F.lane == 0) { tc[i] = mn; tc[128 + i] = mx; } } }
    { bf16* bf = WSP(bf16, WS_S5BF);
      for (int i = gt; i < S5G * 8 * 64; i += NGT) { const int lane = i & 63, nb = (i >> 6) & 7, g = i >> 9; const int n = 16 * nb + (lane & 15), p = n & 63, im = n >> 6, kq = lane >> 4;
          const int gp = g * 64 + p; const float stepf = expf(INF(17)[g]); const double ar = (double)INF(15)[gp], ai = (double)INF(16)[gp];
          float sn_, cn_; sincosf((float)ai * stepf, &sn_, &cn_); const double mag = (double)expf((float)ar * stepf), are = mag * (double)cn_, aim = mag * (double)sn_;
          const double den = ar * ar + ai * ai, nr = are - 1.0, ni = aim, fre = (nr * ar + ni * ai) / den, fim = (ni * ar - nr * ai) / den;
          float f[8];
#pragma unroll
          for (int j = 0; j < 8; ++j) { const int c = 8 * (kq & 1) + j; const double br = (double)INF(18)[(size_t)gp * 16 + c], bi = (double)INF(19)[(size_t)gp * 16 + c];
              const float v = (float)(im ? (fre * bi + fim * br) : (fre * br - fim * bi)); const float hi = bf2f(f2bf(v)); f[j] = (kq < 2) ? hi : (v - hi); }
          *(u32x4*)(bf + (size_t)i * 8) = pack8(f); } }
    { f32x2* abar = WSP(f32x2, WS_S5P); f32x2* apow = abar + 4096; f32x2* bbar = abar + 8192;
      for (int i = gt; i < S5G * S5P; i += NGT) { const int g = i >> 6;
          const float stepf = expf(INF(17)[g]); const double ar = (double)INF(15)[i], ai = (double)INF(16)[i];
          float sn_, cn_; sincosf((float)ai * stepf, &sn_, &cn_); const double mag = (double)expf((float)ar * stepf), are = mag * (double)cn_, aim = mag * (double)sn_;
          const double den = ar * ar + ai * ai, nr = are - 1.0, ni = aim, fre = (nr * ar + ni * ai) / den, fim = (ni * ar - nr * ai) / den;
          abar[i] = (f32x2){(float)are, (float)aim};
          double pr = are, pi = aim;
#pragma unroll 1
          for (int s = 0; s < 6; ++s) { const double tr = pr * pr - pi * pi, ti = 2.0 * pr * pi; pr = tr; pi = ti; }
          apow[i] = (f32x2){(float)pr, (float)pi};
          { double qr = pr, qi = pi;
#pragma unroll 1
            for (int s2 = 0; s2 < 2; ++s2) { const double tr = qr * qr - qi * qi, ti = 2.0 * qr * qi; qr = tr; qi = ti; }
            abar[73728 + i] = (f32x2){(float)qr, (float)qi}; }
          { f32x4 brv[4], biv[4];
#pragma unroll
            for (int c4 = 0; c4 < 4; ++c4) { brv[c4] = *(const f32x4*)(INF(18) + (size_t)i * 16 + 4 * c4); biv[c4] = *(const f32x4*)(INF(19) + (size_t)i * 16 + 4 * c4); }
#pragma unroll
            for (int c4 = 0; c4 < 4; ++c4)
#pragma unroll
                for (int e = 0; e < 4; ++e) { const double br = (double)brv[c4][e], bi = (double)biv[c4][e];
                    bbar[(size_t)i * 16 + 4 * c4 + e] = (f32x2){(float)(fre * br - fim * bi), (float)(fre * bi + fim * br)}; } } } }
}
__device__ __forceinline__ void p0_mod(Frame& F) {
    LAS float* sc = (LAS float*)F.lds;
    LAS float* red = sc + 8192;
    const float* cc = INF(1); const float* wa = INF(3); const float* ba = INF(4); float* mod = WSP(float, WS_MOD);
    for (int i = F.tid; i < NB * DM; i += NTHR) { const float x = cc[i]; sc[i] = x / (1.0f + expf(-x)); }
    __syncthreads();
    for (int ch = F.bid; ch < 256; ch += F.G) {
        const int col0 = ch * 48;
        if (F.tid < 504) {
            const int q = F.tid % 12, r = F.tid / 12;
            f32x4 acc[4]; for (int b = 0; b < 4; ++b) acc[b] = (f32x4){0.f, 0.f, 0.f, 0.f};
            for (int k0 = r; k0 < DM; k0 += 42 * 7) { f32x4 w[7];
#pragma unroll
                for (int u7 = 0; u7 < 7; ++u7) { const int k = k0 + 42 * u7; w[u7] = (k < DM) ? *(const f32x4*)(wa + (size_t)k * 12288 + col0 + 4 * q) : (f32x4){0.f, 0.f, 0.f, 0.f}; }
#pragma unroll
                for (int u7 = 0; u7 < 7; ++u7) { const int k = k0 + 42 * u7; if (k < DM) {
#pragma unroll
                    for (int b = 0; b < 4; ++b) acc[b] += w[u7] * sc[b * DM + k]; } } }
#pragma unroll
            for (int b = 0; b < 4; ++b) *(LAS f32x4*)(red + r * 192 + b * 48 + 4 * q) = acc[b];
        }
        __syncthreads();
        if (F.tid < 192) { float s = 0.f; for (int r = 0; r < 42; ++r) s += red[r * 192 + F.tid]; const int b = F.tid / 48, cl = F.tid % 48; mod[b * 12288 + col0 + cl] = s + ba[col0 + cl]; }
        __syncthreads();
    }
}

template <bool NEXT>
__device__ __forceinline__ void p1_row(Frame& F, const f32x4 (&v)[8], int m, f32x4 (&vn)[8], int mn) {
    const float* g = INF(5); const float* mod = WSP(float, WS_MOD); bf16* H = WSP(bf16, WS_H);
    const int b = m / SEQ; const float* sh = mod + b * 12288; const float* scl = sh + DM;
    int ln = F.lane; asm volatile("" : "+v"(ln));
    f32x4 gg[8], s1[8], s0[8];
#pragma unroll
    for (int j = 0; j < 8; ++j) { const int k = 4 * ln + 256 * j; gg[j] = *(const f32x4*)(g + k); s1[j] = *(const f32x4*)(scl + k); s0[j] = *(const f32x4*)(sh + k); }
    if constexpr (NEXT) { const f32x4* xn = (const f32x4*)(INF(0) + (size_t)mn * DM) + ln;
#pragma unroll
        for (int j = 0; j < 8; ++j) vn[j] = xn[64 * j]; }
    float s = 0.f;
#pragma unroll
    for (int j = 0; j < 8; ++j) s += (v[j].x * v[j].x + v[j].y * v[j].y) + (v[j].z * v[j].z + v[j].w * v[j].w);
    const float rs = 1.0f / sqrtf(wave_sum(s) * (1.0f / DM) + EPS);
    u32x2* o = (u32x2*)(H + (size_t)m * DM) + ln; unsigned* o8 = (unsigned*)(WSP(unsigned char, WS_H2LO) + (size_t)m * DM) + ln;
#pragma unroll
    for (int j = 0; j < 8; ++j) { const f32x4 h = v[j] * rs * gg[j] * (1.0f + s1[j]) + s0[j];
        { const u32x2 hv = (u32x2){pk2(h.x, h.y), pk2(h.z, h.w)}; asm volatile("global_store_dwordx2 %0, %1, off" : : "v"(o + 64 * j), "v"(hv) : "memory"); }
        { const unsigned h8 = pk4_fp8(h.x, h.y, h.z, h.w); asm volatile("global_store_dword %0, %1, off" : : "v"(o8 + 64 * j), "v"(h8) : "memory"); } }
}
__device__ __forceinline__ void p1_h1(Frame& F) {
    const int gw = F.bid * NWAVES + F.wave, NGW = F.G * NWAVES;
    int m = gw; if (m >= NTOK) return;
    f32x4 va[8], vb[8];
    { const f32x4* xa = (const f32x4*)(INF(0) + (size_t)m * DM) + F.lane;
#pragma unroll
      for (int j = 0; j < 8; ++j) va[j] = xa[64 * j]; }
    while (m + 2 * NGW < NTOK) {
        p1_row<true>(F, va, m, vb, m + NGW);
        p1_row<true>(F, vb, m + NGW, va, m + 2 * NGW);
        m += 2 * NGW;
    }
    if (m + NGW < NTOK) { p1_row<true>(F, va, m, vb, m + NGW); p1_row<false>(F, vb, m + NGW, va, 0); }
    else p1_row<false>(F, va, m, vb, 0);
}

struct GUnit { const bf16* A; const int* gl; int gcnt; const bf16* Bt; int orow, ocol, aux; };
struct GridSched {
    const bf16* A; const bf16* Bt; int lda, K, nM, nN, nwg, G, c;
    __device__ void init(const bf16* A_, int lda_, const bf16* Bt_, int K_, int M, int N, int G_, int c_) { A = A_; lda = lda_; Bt = Bt_; K = K_; nM = M / 256; nN = N / 256; nwg = nM * nN; G = G_; c = c_; }
    __device__ bool next(int i, GUnit& u) const {
        const long L = (long)i * G + c; if (L >= nwg) return false;
        int wgid = (int)L; { const int q = nwg / 8, r = nwg % 8, xcd = wgid % 8, off = wgid / 8; wgid = (xcd < r ? xcd * (q + 1) : r * (q + 1) + (xcd - r) * q) + off; }
        const int nig = 8 * nN, gid = wgid / nig, fm = gid * 8, gsz = (nM - fm) < 8 ? (nM - fm) : 8;
        const int pm = fm + ((wgid % nig) % gsz), pn = (wgid % nig) / gsz;
        u.A = A + (size_t)pm * 256 * lda; u.gl = nullptr; u.gcnt = 256; u.Bt = Bt + (size_t)pn * 256 * K; u.orow = pm * 256; u.ocol = pn * 256; u.aux = 0; return true;
    }
};

template <class Sched, class Epi>
__device__ __forceinline__ void gemm_naive(const Sched& S, const Epi& E) {
    GUnit u;
    for (int i = 0; S.next(i, u); ++i) {
        for (int it = threadIdx.x; it < 1024; it += NTHR) {
            const int r = it & 255, wc = it >> 8;
            const bf16* arow = u.gl ? u.A + (size_t)(r < u.gcnt ? u.gl[r] : 0) * S.lda : u.A + (size_t)r * S.lda;
            float part = 0.f;
#pragma unroll 1
            for (int fq = 0; fq < 4; ++fq) {
                const int c = 32 * wc + 8 * fq;
                float v0[8], v1[8];
#pragma unroll
                for (int j = 0; j < 8; ++j) { v0[j] = 0.f; v1[j] = 0.f; }
#pragma unroll 1
                for (int k = 0; k < S.K; k += 8) {
                    float a[8]; unpack8(*(const u32x4*)(arow + k), a);
#pragma unroll
                    for (int j = 0; j < 8; ++j) {
                        float b0[8], b1[8]; unpack8(*(const u32x4*)(u.Bt + (size_t)(c + j) * S.K + k), b0); unpack8(*(const u32x4*)(u.Bt + (size_t)(128 + c + j) * S.K + k), b1);
#pragma unroll
                        for (int q = 0; q < 8; ++q) { v0[j] += a[q] * b0[q]; v1[j] += a[q] * b1[q]; }
                    }
                }
#pragma unroll
                for (int j = 0; j < 8; ++j) part += v0[j] * v0[j] + v1[j] * v1[j];
                E.apply(u, r, c, v0, v1, E.begin(u, c));
            }
            if (Epi::ROWPART) E.rowpart(u, r, wc, part);
        }
    }
}

struct EpiG1 {
    static constexpr bool ROWPART = true, PREFETCH = false;
    struct St {}; __device__ __forceinline__ St begin(const GUnit&, int) const { return St{}; }
    bf16 *QL, *KVL, *U, *SGM, *SGS; float* RSS; int pn0;
    __device__ __forceinline__ void st(bf16* base, int ld, int row, int col, const float (&v)[8], bool sg) const {
        float f[8];
#pragma unroll
        for (int j = 0; j < 8; ++j) f[j] = sg ? sigm(v[j]) : v[j];
        *(u32x4*)(base + (size_t)row * ld + col) = pack8(f);
    }
    __device__ __forceinline__ void apply(const GUnit& u, int r, int c, const float (&v0)[8], const float (&v1)[8], const St&) const {
        const int pn = pn0 + (u.ocol >> 8), row = u.orow + r; bf16* base; int ld, col; bool sg = false;
        if (pn < 2) { base = QL; ld = QLORA; col = pn * 256; } else if (pn < 4) { base = KVL; ld = KVLORA; col = (pn - 2) * 256; } else if (pn < 8) { base = U; ld = S5CH; col = (pn - 4) * 256; }
        else if (pn < 16) { base = SGM; ld = DM; col = (pn - 8) * 256; sg = true; } else { base = SGS; ld = DM; col = (pn - 16) * 256; sg = true; }
        st(base, ld, row, col + c, v0, sg); st(base, ld, row, col + 128 + c, v1, sg);
    }
    __device__ __forceinline__ void rowpart(const GUnit& u, int r, int wc, float part) const {
        const int pn = pn0 + (u.ocol >> 8); if (pn < 4) RSS[(size_t)(pn >> 1) * NTOK * 8 + (size_t)(u.orow + r) * 8 + (pn & 1) * 4 + wc] = part;
    }
};
__device__ __forceinline__ float rs_from_parts(const float* p) { const f32x4 a = *(const f32x4*)p, b = *(const f32x4*)(p + 4); const float s = ((a.x + a.y) + (a.z + a.w)) + ((b.x + b.y) + (b.z + b.w)); return 1.0f / sqrtf(s * (1.0f / 512.0f) + EPS); }
struct P3Sched {
    const bf16 *QL, *KVL, *WUQ, *WUKV; int lda, K, G, c;
    __device__ bool next(int i, GUnit& u) const {
        int L = i * G + c; u.gl = nullptr; u.gcnt = 256;
        if (L < 192) { const int pm = L / 6, pn = L % 6; u.A = QL + (size_t)pm * 256 * 512; u.Bt = WUQ + (size_t)pn * 256 * 512; u.orow = pm * 256; u.ocol = pn * 256; u.aux = 0; return true; }
        L -= 192;
        if (L < 128) { const int pm = L / 4, pn = L % 4; u.A = KVL + (size_t)pm * 256 * 512; u.Bt = WUKV + (size_t)pn * 256 * 512; u.orow = pm * 256; u.ocol = pn * 256; u.aux = 1; return true; }
        L -= 128;
        if (L < 128) { const int pm = L % 4, pn = L / 4; u.A = WUKV + (size_t)(1024 + pm * 256) * 512; u.Bt = KVL + (size_t)pn * 256 * 512; u.orow = pm * 256; u.ocol = pn * 256; u.aux = 2; return true; }
        return false;
    }
};
struct EpiP3 {
    static constexpr bool ROWPART = false, PREFETCH = true; template <int V> static constexpr int pfb() { return V == 1 ? 4 : 2; }
    bf16 *Q, *KN, *VT; const float* RSS; const f32x2* CS;
    struct St { float c0[8], c1[8]; };
    struct Ld { f32x4 p0, p1, t[2][2]; };
    __device__ __forceinline__ St begin(const GUnit& u, int c) const { St st;
#pragma unroll
        for (int j = 0; j < 8; ++j) { st.c0[j] = 0.f; st.c1[j] = 0.f; }
        if (u.aux == 2) {
#pragma unroll
            for (int hb = 0; hb < 4; ++hb) { const int half = hb >> 1, jb = (hb & 1) * 4; f32x4 pa[4], pb[4];
#pragma unroll
                for (int q = 0; q < 4; ++q) { const float* p = RSS + (size_t)NTOK * 8 + (size_t)(u.ocol + 128 * half + c + jb + q) * 8; pa[q] = *(const f32x4*)p; pb[q] = *(const f32x4*)(p + 4); }
                __builtin_amdgcn_sched_barrier(0);
#pragma unroll
                for (int q = 0; q < 4; ++q) { const f32x4 a = pa[q], b = pb[q]; const float sm = ((a.x + a.y) + (a.z + a.w)) + ((b.x + b.y) + (b.z + b.w)); const float rs = 1.0f / sqrtf(sm * (1.0f / 512.0f) + EPS);
                    if (half) st.c1[jb + q] = rs; else st.c0[jb + q] = rs; }
                __builtin_amdgcn_sched_barrier(0); } }
        return st; }
    __device__ __forceinline__ int variant(const GUnit& u) const { return u.aux; }
    template <int V> __device__ __forceinline__ void load(const GUnit& u, int r, int c, const St&, Ld& L) const {
        const f32x4 z = (f32x4){0.f, 0.f, 0.f, 0.f}; L.p0 = z; L.p1 = z; L.t[0][0] = z; L.t[0][1] = z; L.t[1][0] = z; L.t[1][1] = z;
        if (V == 2) return;
        const float* p = RSS + (V == 1 ? (size_t)NTOK * 8 : (size_t)0) + (size_t)(u.orow + r) * 8; L.p0 = *(const f32x4*)p; L.p1 = *(const f32x4*)(p + 4);
        if (V == 0) {
#pragma unroll
            for (int h = 0; h < 2; ++h) { const int w = (u.ocol + c + 128 * h) % DQK;
                if (w >= DNOPE) { const f32x4* cs = (const f32x4*)(CS + (size_t)(u.orow + r) * 32 + 4 * ((w - DNOPE) >> 3)); L.t[h][0] = cs[0]; L.t[h][1] = cs[1]; } } }
    }
    template <int V> __device__ __forceinline__ void one(const GUnit& u, int r, int ct, const float (&v)[8], float rs, const float (&cs8)[8], const f32x4& t0, const f32x4& t1) const {
        const int row = u.orow + r, n = u.ocol + ct;
        if (V == 0) {
            const int h = n / DQK, w = n % DQK;
            if (w < DNOPE) { float f[8];
#pragma unroll
                for (int j = 0; j < 8; ++j) f[j] = v[j] * rs;
                *(u32x4*)(Q + (size_t)row * 1536 + n) = pack8(f); }
            else { const int a = (w - DNOPE) >> 3; const float tc[4] = {t0.x, t0.z, t1.x, t1.z}, ts[4] = {t0.y, t0.w, t1.y, t1.w}; float o1[4], o2[4];
#pragma unroll
                for (int j = 0; j < 4; ++j) { const float x1 = v[j] * rs, x2 = v[4 + j] * rs; o1[j] = x1 * tc[j] - x2 * ts[j]; o2[j] = x2 * tc[j] + x1 * ts[j]; }
                bf16* qp = Q + (size_t)row * 1536 + h * DQK + DNOPE + 4 * a;
                *(u32x2*)qp = (u32x2){pk2(o1[0], o1[1]), pk2(o1[2], o1[3])}; *(u32x2*)(qp + 32) = (u32x2){pk2(o2[0], o2[1]), pk2(o2[2], o2[3])}; }
        } else if (V == 1) {
            float f[8];
#pragma unroll
            for (int j = 0; j < 8; ++j) f[j] = v[j] * rs;
            *(u32x4*)(KN + (size_t)row * 1024 + n) = pack8(f);
        } else {
            float f[8];
#pragma unroll
            for (int j = 0; j < 8; ++j) f[j] = v[j] * cs8[j];
            *(u32x4*)(VT + (size_t)row * NTOK + n) = pack8(f);
        }
    }
    template <int V> __device__ __forceinline__ void apply(const GUnit& u, int r, int c, const float (&v0)[8], const float (&v1)[8], const St& st, const Ld& L) const {
        float rs = 0.f;
        if (V != 2) { const f32x4 a = L.p0, b = L.p1; const float s = ((a.x + a.y) + (a.z + a.w)) + ((b.x + b.y) + (b.z + b.w)); rs = 1.0f / sqrtf(s * (1.0f / 512.0f) + EPS); if (V == 0) rs *= QSCALE; }
        one<V>(u, r, c, v0, rs, st.c0, L.t[0][0], L.t[0][1]); one<V>(u, r, 128 + c, v1, rs, st.c1, L.t[1][0], L.t[1][1]); }
    __device__ __forceinline__ void apply(const GUnit& u, int r, int c, const float (&v0)[8], const float (&v1)[8], const St& st) const { Ld L;
        if (u.aux == 0) { load<0>(u, r, c, st, L); apply<0>(u, r, c, v0, v1, st, L); } else if (u.aux == 1) { load<1>(u, r, c, st, L); apply<1>(u, r, c, v0, v1, st, L); } else { load<2>(u, r, c, st, L); apply<2>(u, r, c, v0, v1, st, L); } }
    __device__ __forceinline__ void rowpart(const GUnit&, int, int, float) const {}
};
struct P5Sched {
    const bf16 *AO, *WBRM, *YG, *WGLU; int lda, K, G, c;
    __device__ bool next(int i, GUnit& u) const {
        int L = i * G + c; u.gl = nullptr; u.gcnt = 256;
        if (L < 128) { const int pm = L / 4, pn = L % 4; u.A = YG + (size_t)pm * 256 * 1024; u.Bt = WGLU + (size_t)pn * 256 * 1024; u.orow = pm * 256; u.ocol = pn * 256; u.aux = 1; return true; }
        L -= 128;
        if (L < 256) { const int pm = L / 8, pn = L % 8; u.A = AO + (size_t)pm * 256 * 1024; u.Bt = WBRM + (size_t)pn * 256 * 1024; u.orow = pm * 256; u.ocol = pn * 256; u.aux = 0; return true; }
        return false;
    }
};
struct EpiP5 {
    static constexpr bool ROWPART = false, PREFETCH = false;
    struct St {}; __device__ __forceinline__ St begin(const GUnit&, int) const { return St{}; }
    bf16 *M1, *S5O; const bf16 *SGM, *YG;
    __device__ __forceinline__ void one(const GUnit& u, int r, int ct, const float (&v)[8]) const {
        const int row = u.orow + r, n = u.ocol + ct; float g[8], f[8];
        if (u.aux == 0) { unpack8(*(const u32x4*)(SGM + (size_t)row * DM + n), g);
#pragma unroll
            for (int j = 0; j < 8; ++j) f[j] = g[j] * v[j];
            *(u32x4*)(M1 + (size_t)row * DM + n) = pack8(f); }
        else { unpack8(*(const u32x4*)(YG + (size_t)row * S5CH + n), g);
#pragma unroll
            for (int j = 0; j < 8; ++j) f[j] = g[j] * sigm(v[j]);
            *(u32x4*)(S5O + (size_t)row * S5CH + n) = pack8(f); }
    }
    __device__ __forceinline__ void apply(const GUnit& u, int r, int c, const float (&v0)[8], const float (&v1)[8], const St&) const { one(u, r, c, v0); one(u, r, 128 + c, v1); }
    __device__ __forceinline__ void rowpart(const GUnit&, int, int, float) const {}
};
struct GluSched {
    const bf16 *YG, *WGLU; int lda, K, G, c;
    __device__ __forceinline__ void a_ready(const GUnit&) const {}
    __device__ __forceinline__ void done(const GUnit&) const {}
    __device__ bool next(int i, GUnit& u) const {
        const int L = i * G + c; if (L >= 256) return false;
        const int ph = L >> 2, pn = L & 3; u.gl = nullptr; u.gcnt = 128; u.A = YG + (size_t)ph * 128 * 1024; u.Bt = WGLU + (size_t)pn * 256 * 1024; u.orow = ph * 128; u.ocol = pn * 256; u.aux = 1; return true;
    }
};
struct PairSched {
    const bf16 *AO, *WBRM, *S5O, *WBRS; int lda, K, G, c;
    __device__ __forceinline__ void a_ready(const GUnit&) const {}
    __device__ __forceinline__ void done(const GUnit&) const {}
    __device__ bool next(int i, GUnit& u) const {
        const int pair = (i >> 1) * G + c, which = i & 1; if (pair >= 256) return false;
        int wgid = pair; { const int q = 256 / 8, xcd = wgid % 8, off = wgid / 8; wgid = xcd * q + off; }
        const int nig = 8 * 8, gid = wgid / nig, fm = gid * 8; const int pm = fm + ((wgid % nig) % 8), pn = (wgid % nig) / 8;
        u.gl = nullptr; u.gcnt = 256; u.orow = pm * 256; u.ocol = pn * 256;
        if (which == 0) { u.A = AO + (size_t)pm * 256 * 1024; u.Bt = WBRM + (size_t)pn * 256 * 1024; u.aux = 0; }
        else { u.A = S5O + (size_t)pm * 256 * 1024; u.Bt = WBRS + (size_t)pn * 256 * 1024; u.aux = 2; }
        return true;
    }
};
struct EpiMix {
    static constexpr bool ROWPART = false, PREFETCH = true; template <int V> static constexpr int pfb() { return V == 2 ? 2 : 8; }
    struct St {}; __device__ __forceinline__ St begin(const GUnit&, int) const { return St{}; }
    struct Ld { u32x4 g[2], m[2]; };
    bf16 *M1, *S5O; const bf16 *SGM, *SGS, *YG;
    __device__ __forceinline__ int variant(const GUnit& u) const { return u.aux; }
    template <int V> __device__ __forceinline__ void load(const GUnit& u, int r, int c, const St&, Ld& L) const {
        const int row = u.orow + r;
#pragma unroll
        for (int h = 0; h < 2; ++h) { const int n = u.ocol + c + 128 * h; L.g[h] = (u32x4){0u, 0u, 0u, 0u}; L.m[h] = (u32x4){0u, 0u, 0u, 0u};
            if (V == 0) L.g[h] = *(const u32x4*)(SGM + (size_t)row * DM + n);
            else if (V == 1) { if (r < u.gcnt) L.g[h] = *(const u32x4*)(YG + (size_t)row * S5CH + n); }
            else { L.g[h] = *(const u32x4*)(SGS + (size_t)row * DM + n); L.m[h] = *(const u32x4*)(M1 + (size_t)row * DM + n); } }
    }
    template <int V> __device__ __forceinline__ void one(const GUnit& u, int r, int ct, const float (&v)[8], const u32x4& gq, const u32x4& mq) const {
        const int row = u.orow + r, n = u.ocol + ct; float g[8], f[8]; unpack8(gq, g);
        if (V == 0) {
#pragma unroll
            for (int j = 0; j < 8; ++j) f[j] = g[j] * v[j];
            *(u32x4*)(M1 + (size_t)row * DM + n) = pack8(f); }
        else if (V == 1) { if (r >= u.gcnt) return;
#pragma unroll
            for (int j = 0; j < 8; ++j) f[j] = g[j] * sigm(v[j]);
            *(u32x4*)(S5O + (size_t)row * S5CH + n) = pack8(f); }
        else { float m[8]; unpack8(mq, m);
#pragma unroll
            for (int j = 0; j < 8; ++j) f[j] = m[j] + g[j] * v[j];
            *(u32x4*)(M1 + (size_t)row * DM + n) = pack8(f); }
    }
    template <int V> __device__ __forceinline__ void apply(const GUnit& u, int r, int c, const float (&v0)[8], const float (&v1)[8], const St&, const Ld& L) const { one<V>(u, r, c, v0, L.g[0], L.m[0]); one<V>(u, r, 128 + c, v1, L.g[1], L.m[1]); }
    __device__ __forceinline__ void apply(const GUnit& u, int r, int c, const float (&v0)[8], const float (&v1)[8], const St& st) const { Ld L;
        if (u.aux == 0) { load<0>(u, r, c, st, L); apply<0>(u, r, c, v0, v1, st, L); } else if (u.aux == 1) { load<1>(u, r, c, st, L); apply<1>(u, r, c, v0, v1, st, L); } else { load<2>(u, r, c, st, L); apply<2>(u, r, c, v0, v1, st, L); } }
    __device__ __forceinline__ void rowpart(const GUnit&, int, int, float) const {}
};
struct EpiP6 {
    static constexpr bool ROWPART = false, PREFETCH = false;
    struct St {}; __device__ __forceinline__ St begin(const GUnit&, int) const { return St{}; }
    bf16* M1; const bf16* SGS;
    __device__ __forceinline__ void one(const GUnit& u, int r, int ct, const float (&v)[8]) const {
        const int row = u.orow + r, n = u.ocol + ct; float g[8], m[8], f[8];
        unpack8(*(const u32x4*)(SGS + (size_t)row * DM + n), g); unpack8(*(const u32x4*)(M1 + (size_t)row * DM + n), m);
#pragma unroll
        for (int j = 0; j < 8; ++j) f[j] = m[j] + g[j] * v[j];
        *(u32x4*)(M1 + (size_t)row * DM + n) = pack8(f);
    }
    __device__ __forceinline__ void apply(const GUnit& u, int r, int c, const float (&v0)[8], const float (&v1)[8], const St&) const { one(u, r, c, v0); one(u, r, 128 + c, v1); }
    __device__ __forceinline__ void rowpart(const GUnit&, int, int, float) const {}
};
struct EpiBf16Plain {
    static constexpr bool ROWPART = false, PREFETCH = false;
    struct St {}; __device__ __forceinline__ St begin(const GUnit&, int) const { return St{}; }
    bf16* C; int ldc;
    __device__ __forceinline__ void apply(const GUnit& u, int r, int c, const float (&v0)[8], const float (&v1)[8], const St&) const {
        bf16* p = C + (size_t)(u.orow + r) * ldc + u.ocol + c; *(u32x4*)p = pack8(v0); *(u32x4*)(p + 128) = pack8(v1);
    }
    __device__ __forceinline__ void rowpart(const GUnit&, int, int, float) const {}
};
struct EpiF32 {
    static constexpr bool ROWPART = false, PREFETCH = false;
    struct St {}; __device__ __forceinline__ St begin(const GUnit&, int) const { return St{}; }
    float* C; int ldc;
    __device__ __forceinline__ void one(const GUnit& u, int r, int ct, const float (&v)[8]) const {
        float* p = C + (size_t)(u.orow + r) * ldc + u.ocol + ct; *(f32x4*)p = (f32x4){v[0], v[1], v[2], v[3]}; *(f32x4*)(p + 4) = (f32x4){v[4], v[5], v[6], v[7]};
    }
    __device__ __forceinline__ void apply(const GUnit& u, int r, int c, const float (&v0)[8], const float (&v1)[8], const St&) const { one(u, r, c, v0); one(u, r, 128 + c, v1); }
    __device__ __forceinline__ void rowpart(const GUnit&, int, int, float) const {}
};
struct MoeTab { LAS int* mtoff; LAS int* cnt; };
__device__ __forceinline__ void moe_build_tab(Frame& F, const MoeTab& T) {
    const unsigned* gc = WSP(unsigned, WS_CTL) + CW_CNT;
    if (F.tid < 64) { const int e = F.tid; const int c = (int)gc[e]; T.cnt[e] = c; int nt = (c + 255) >> 8, inc = nt;
#pragma unroll
        for (int o = 1; o < 64; o <<= 1) { const int t = __shfl_up(inc, o); if (e >= o) inc += t; }
        T.mtoff[e] = inc - nt; if (e == 63) { T.mtoff[64] = inc; T.mtoff[65] = inc + 32; } }
    __syncthreads();
}
__device__ __forceinline__ int moe_find_e(const MoeTab& T, int mt) { int e = 0;
#pragma unroll 1
    for (int s = 64; s >= 1; s >>= 1) { if (e + s <= 64 && T.mtoff[e + s] <= mt) e += s; }
    return e; }
template <int NPN, bool DOWN>
struct MoeSched {
    MoeTab T; const bf16* Ain; const bf16* AinS; const bf16* W; const int* rowtok; int lda, K, G, c;
    __device__ bool next(int i, GUnit& u) const {
        const int L = i * G + c; const int TM = T.mtoff[65]; if (L >= TM * NPN) return false;
        const int mt = L / NPN, pn = L % NPN; const int e = moe_find_e(T, mt); const int ml = mt - T.mtoff[e];
        u.aux = e; u.ocol = pn * 256; u.gl = nullptr; u.gcnt = 256;
        if (!DOWN) {
            u.Bt = W + (size_t)e * 1024 * K + (size_t)pn * 256 * K;
            if (e < NE) { u.A = Ain; u.gl = rowtok + (size_t)e * NTOK + ml * 256; u.gcnt = T.cnt[e] - ml * 256; u.orow = mt * 256; }
            else { u.A = Ain + (size_t)ml * 256 * K; u.orow = ml * 256; }
        } else {
            u.Bt = W + (size_t)e * DM * K + (size_t)pn * 256 * K;
            if (e < NE) { u.A = Ain + (size_t)mt * 256 * K; u.orow = mt * 256; u.gcnt = T.cnt[e] - ml * 256; } else { u.A = AinS + (size_t)ml * 256 * K; u.orow = ml * 256; }
        }
        return true;
    }
};
struct EpiGU {
    static constexpr bool ROWPART = false, PREFETCH = false;
    struct St {}; __device__ __forceinline__ St begin(const GUnit&, int) const { return St{}; }
    bf16 *ACT, *ACTS;
    __device__ __forceinline__ void apply(const GUnit& u, int r, int c, const float (&v0)[8], const float (&v1)[8], const St&) const {
        float f[8];
#pragma unroll
        for (int j = 0; j < 8; ++j) f[j] = v0[j] * sigm(v0[j]) * v1[j];
        if (r >= u.gcnt) return;
        unsigned char* base = (unsigned char*)((u.aux < NE) ? ACT : ACTS);
        *(u32x2*)(base + (size_t)(u.orow + r) * DE + (u.ocol >> 1) + c) = (u32x2){pk4_fp8(f[0] * ACT_SCALE, f[1] * ACT_SCALE, f[2] * ACT_SCALE, f[3] * ACT_SCALE), pk4_fp8(f[4] * ACT_SCALE, f[5] * ACT_SCALE, f[6] * ACT_SCALE, f[7] * ACT_SCALE)};
    }
    __device__ __forceinline__ void rowpart(const GUnit&, int, int, float) const {}
};
struct EpiDown {
    static constexpr bool ROWPART = false, PREFETCH = false;
    struct St {}; __device__ __forceinline__ St begin(const GUnit&, int) const { return St{}; }
    bf16 *Y, *YS;
    __device__ __forceinline__ void apply(const GUnit& u, int r, int c, const float (&v0)[8], const float (&v1)[8], const St&) const {
        if (r >= u.gcnt) return;
        unsigned char* p = (unsigned char*)((u.aux < NE) ? Y : YS) + (size_t)(u.orow + r) * DM + u.ocol + c;
        *(u32x2*)p = (u32x2){pk4_fp8(v0[0] * Y_SCALE, v0[1] * Y_SCALE, v0[2] * Y_SCALE, v0[3] * Y_SCALE), pk4_fp8(v0[4] * Y_SCALE, v0[5] * Y_SCALE, v0[6] * Y_SCALE, v0[7] * Y_SCALE)};
        *(u32x2*)(p + 128) = (u32x2){pk4_fp8(v1[0] * Y_SCALE, v1[1] * Y_SCALE, v1[2] * Y_SCALE, v1[3] * Y_SCALE), pk4_fp8(v1[4] * Y_SCALE, v1[5] * Y_SCALE, v1[6] * Y_SCALE, v1[7] * Y_SCALE)};
    }
    __device__ __forceinline__ void rowpart(const GUnit&, int, int, float) const {}
};

namespace pg8 {
typedef int v4i32 __attribute__((ext_vector_type(4)));
typedef int v8i32 __attribute__((ext_vector_type(8)));
constexpr int BM = 256, BK = 64, HALF = 128, HTB = HALF * BK * 2, STAGE_BYTES = 8 * HTB;
__device__ __forceinline__ int lds_byte(int r, int c) { const int st = (r >> 4) * 2 + (c >> 5), rr = r & 15, cc = c & 31, ob = rr * 64 + cc * 2; return st * 1024 + (ob ^ (((ob >> 9) & 1) << 5)); }
__device__ __forceinline__ void stage_rc(int b, int& R, int& C) { const int st = b / 1024, sb = b % 1024, swz = sb ^ (((sb >> 9) & 1) << 5); R = (st >> 1) * 16 + swz / 64; C = (st & 1) * 32 + (swz % 64) / 2; }
__device__ __forceinline__ int perm32(int rho) { const int n = rho >> 4, i = rho & 15; return 8 * (i >> 2) + 4 * n + (i & 3); }

template <class Epi, int V>
__device__ __forceinline__ void run_epi_pf(const Epi& E, const GUnit& u, const f32x4 (&acc)[2][2][4][2], int wr, int wc, int fr, int fq, const typename Epi::St& st) {
    constexpr int PFB = Epi::template pfb<V>(); const int c = wc * 32 + 8 * fq;
#pragma unroll
    for (int b0 = 0; b0 < 8; b0 += PFB) {
        typename Epi::Ld ld[PFB];
#pragma unroll
        for (int q = 0; q < PFB; ++q) { const int ai = (b0 + q) >> 2, m = (b0 + q) & 3; E.template load<V>(u, ai * HALF + wr * 64 + m * 16 + fr, c, st, ld[q]); }
#pragma unroll
        for (int q = 0; q < PFB; ++q) { const int ai = (b0 + q) >> 2, m = (b0 + q) & 3; const int r = ai * HALF + wr * 64 + m * 16 + fr;
            float v0[8], v1[8];
#pragma unroll
            for (int j = 0; j < 4; ++j) { v0[j] = acc[ai][0][m][0][j]; v0[4 + j] = acc[ai][0][m][1][j]; v1[j] = acc[ai][1][m][0][j]; v1[4 + j] = acc[ai][1][m][1][j]; }
            E.template apply<V>(u, r, c, v0, v1, st, ld[q]); }
    }
}
template <class Epi>
__device__ __forceinline__ void run_epi(const Epi& E, const GUnit& u, const f32x4 (&acc)[2][2][4][2], int wr, int wc, int fr, int fq) {
    const typename Epi::St st = E.begin(u, wc * 32 + 8 * fq);
    if constexpr (Epi::PREFETCH) {
        const int var = E.variant(u);
        if (var == 0) run_epi_pf<Epi, 0>(E, u, acc, wr, wc, fr, fq, st); else if (var == 1) run_epi_pf<Epi, 1>(E, u, acc, wr, wc, fr, fq, st); else run_epi_pf<Epi, 2>(E, u, acc, wr, wc, fr, fq, st);
    } else {
#pragma unroll
    for (int ai = 0; ai < 2; ++ai)
#pragma unroll
        for (int m = 0; m < 4; ++m) {
            const int r = ai * HALF + wr * 64 + m * 16 + fr, c = wc * 32 + 8 * fq;
            float v0[8], v1[8];
#pragma unroll
            for (int j = 0; j < 4; ++j) { v0[j] = acc[ai][0][m][0][j]; v0[4 + j] = acc[ai][0][m][1][j]; v1[j] = acc[ai][1][m][0][j]; v1[4 + j] = acc[ai][1][m][1][j]; }
            E.apply(u, r, c, v0, v1, st);
            if (Epi::ROWPART) { float part = 0.f;
#pragma unroll
                for (int j = 0; j < 8; ++j) part += v0[j] * v0[j] + v1[j] * v1[j];
                part += __shfl_xor(part, 16); part += __shfl_xor(part, 32);
                if (fq == 0) E.rowpart(u, r, wc, part); }
        }
    }
}

template <class Sched, class Epi, bool GATHER, bool HALFSKIP, int FP8W = 0, int FP8A = 0>
__device__ __forceinline__ void gemm_phase(LAS unsigned char* lds, const Sched& S, const Epi& E) {
    const int tid = threadIdx.x, wid = __builtin_amdgcn_readfirstlane(tid >> 6), lane = tid & 63, wr = wid >> 2, wc = wid & 3, fr = lane & 15, fq = lane >> 4;
    const int K = S.K, nt = K / BK, lda = S.lda;
    int RA[2], CA[2]; unsigned voffB[2];
#pragma unroll
    for (int i = 0; i < 2; ++i) { int R, C; stage_rc(tid * 16 + i * 8192, R, C); RA[i] = R; CA[i] = C; const int Rb = (R & ~31) + perm32(R & 31); voffB[i] = (unsigned)(Rb * K + C) * 2u; }
    const size_t kstep = (size_t)(BK * 2);
    const size_t hstepB = (size_t)HALF * K * 2;
    const unsigned ldsw = (unsigned)wid * 1024u;
    const int aoff = lds_byte(wr * 64 + fr, fq * 8), boff = lds_byte(wc * 32 + fr, fq * 8);
#define PG8_SA(b, h) (((b) * 2 + (h)) * HTB)
#define PG8_SB(b, h) ((4 + (b) * 2 + (h)) * HTB)
#define PG8_STAGE(bufoff, gbase, v0_, v1_) do { \
        __builtin_amdgcn_global_load_lds((const unsigned*)((const char*)(gbase) + (v0_)), (LAS unsigned*)(lds + (bufoff) + ldsw), 16, 0, 0); \
        __builtin_amdgcn_global_load_lds((const unsigned*)((const char*)(gbase) + (v1_)), (LAS unsigned*)(lds + (bufoff) + ldsw + 8192), 16, 0, 0); } while (0)
#define PG8_STAGEB(bufoff, gbase) PG8_STAGE(bufoff, gbase, voffB[0], voffB[1])
#define PG8_LDA(dst, b, h) do { if constexpr (FP8W != 0) { _Pragma("unroll") for (int m = 0; m < 4; ++m) { const v4i32 lo_ = *(const LAS v4i32*)(lds + PG8_SA(b, h) + aoff + m * 2048), hi_ = *(const LAS v4i32*)(lds + PG8_SA(b, h) + aoff + m * 2048 + 1024); \
            dst##8[m] = __builtin_shufflevector(lo_, hi_, 0, 1, 2, 3, 4, 5, 6, 7); } } \
        else { _Pragma("unroll") for (int m = 0; m < 4; ++m) _Pragma("unroll") for (int k = 0; k < 2; ++k) dst[m][k] = *(const LAS bf16x8*)(lds + PG8_SA(b, h) + aoff + m * 2048 + k * 1024); } } while (0)
#define PG8_LDB(dst, b, h) do { if constexpr (FP8W != 0) { _Pragma("unroll") for (int n = 0; n < 2; ++n) { const v4i32 lo_ = *(const LAS v4i32*)(lds + PG8_SB(b, h) + boff + n * 2048), hi_ = *(const LAS v4i32*)(lds + PG8_SB(b, h) + boff + n * 2048 + 1024); \
            dst##8[n] = __builtin_shufflevector(lo_, hi_, 0, 1, 2, 3, 4, 5, 6, 7); } } \
        else { _Pragma("unroll") for (int n = 0; n < 2; ++n) _Pragma("unroll") for (int k = 0; k < 2; ++k) dst[n][k] = *(const LAS bf16x8*)(lds + PG8_SB(b, h) + boff + n * 2048 + k * 1024); } } while (0)
#define PG8_MMA(ai, bj, At, Bt) do { __builtin_amdgcn_s_setprio(1); \
        if constexpr (FP8W != 0) { _Pragma("unroll") for (int m = 0; m < 4; ++m) _Pragma("unroll") for (int n = 0; n < 2; ++n) \
            asm volatile("v_mfma_scale_f32_16x16x128_f8f6f4 %0, %1, %2, %0, %3, %4 op_sel_hi:[0,0,0]" : "+v"(acc[ai][bj][m][n]) : "v"(Bt##8[n]), "v"(At##8[m]), "v"(sclW), "v"(sclA)); } \
        else { _Pragma("unroll") for (int m = 0; m < 4; ++m) _Pragma("unroll") for (int n = 0; n < 2; ++n) _Pragma("unroll") for (int k = 0; k < 2; ++k) \
            acc[ai][bj][m][n] = __builtin_amdgcn_mfma_f32_16x16x32_bf16(Bt[n][k], At[m][k], acc[ai][bj][m][n], 0, 0, 0); } \
        __builtin_amdgcn_s_setprio(0); } while (0)
#define PG8_WAIT_V(n) asm volatile("s_waitcnt vmcnt(" #n ")" ::: "memory")
#define PG8_WAIT_L(n) asm volatile("s_waitcnt lgkmcnt(" #n ")" ::: "memory")
#define PG8_BAR __builtin_amdgcn_s_barrier()
#define PG8_SCHED __builtin_amdgcn_sched_barrier(0)
#define PG8_VOFF(u, dst) do { _Pragma("unroll") for (int h = 0; h < 2; ++h) _Pragma("unroll") for (int i = 0; i < 2; ++i) { const int row = h * HALF + RA[i]; \
        if (GATHER && (u).gl) { const int tok = (row < (u).gcnt) ? (u).gl[row] : 0; dst[h][i] = (unsigned)(tok * lda + CA[i]) * 2u; } \
        else dst[h][i] = (unsigned)(row * lda + CA[i]) * 2u; } } while (0)
    GUnit cur, nxt; int ui = 0;
    if (!S.next(0, cur)) return;
    f32x4 acc[2][2][4][2];
#pragma unroll
    for (int a = 0; a < 2; ++a)
#pragma unroll
        for (int b = 0; b < 2; ++b)
#pragma unroll
            for (int m = 0; m < 4; ++m)
#pragma unroll
                for (int n = 0; n < 2; ++n) acc[a][b][m][n] = (f32x4){0.f, 0.f, 0.f, 0.f};
    bf16x8 At[4][2], B0[2][2], B1[2][2]; v8i32 At8[4], B08[2], B18[2];
    const int sclW = FP8W * 0x01010101, sclA = FP8A * 0x01010101;
    unsigned vA[2][2], vN[2][2];
    PG8_VOFF(cur, vA);
    const char* cA = (const char*)cur.A; const char* cB = (const char*)cur.Bt;
    PG8_STAGEB(PG8_SB(0, 0), cB); PG8_STAGEB(PG8_SB(0, 1), cB + hstepB); PG8_STAGE(PG8_SA(0, 0), cA, vA[0][0], vA[0][1]); PG8_STAGE(PG8_SA(0, 1), cA, vA[1][0], vA[1][1]);
    if (wr == 1) PG8_BAR;
    PG8_WAIT_V(2); PG8_BAR;
    PG8_STAGEB(PG8_SB(1, 0), cB + kstep); PG8_STAGE(PG8_SA(1, 0), cA + kstep, vA[0][0], vA[0][1]); PG8_STAGEB(PG8_SB(1, 1), cB + hstepB + kstep);
    PG8_WAIT_V(6); PG8_BAR;
    for (;;) {
        const bool has_next = S.next(ui + 1, nxt);
        if (has_next) { PG8_VOFF(nxt, vN); } else {
#pragma unroll
            for (int h = 0; h < 2; ++h)
#pragma unroll
                for (int i = 0; i < 2; ++i) vN[h][i] = vA[h][i]; }
        const char* nA = has_next ? (const char*)nxt.A : cA; const char* nB = has_next ? (const char*)nxt.Bt : cB;
        const bool full = !HALFSKIP || cur.gcnt > HALF;
        for (int t = 0; t < nt; t += 2) {
            const bool last = (t == nt - 2);
            const char* a1 = cA + (size_t)(t + 1) * kstep;
            const char* a2 = last ? nA : cA + (size_t)(t + 2) * kstep; const char* b2 = last ? nB : cB + (size_t)(t + 2) * kstep;
            const char* a3 = a2 + kstep; const char* b3 = b2 + kstep;
            const unsigned w00 = last ? vN[0][0] : vA[0][0], w01 = last ? vN[0][1] : vA[0][1], w10 = last ? vN[1][0] : vA[1][0], w11 = last ? vN[1][1] : vA[1][1];
            PG8_LDB(B0, 0, 0); PG8_LDB(B1, 0, 1); PG8_SCHED; PG8_LDA(At, 0, 0); PG8_STAGE(PG8_SA(1, 1), a1, vA[1][0], vA[1][1]);
            PG8_WAIT_V(8); PG8_WAIT_L(0); PG8_BAR; PG8_MMA(0, 0, At, B0); PG8_MMA(0, 1, At, B1); PG8_BAR; PG8_SCHED;
            if (full) { PG8_LDA(At, 0, 1); } PG8_STAGEB(PG8_SB(0, 0), b2); PG8_STAGEB(PG8_SB(0, 1), b2 + hstepB); PG8_STAGE(PG8_SA(0, 0), a2, w00, w01);
            PG8_WAIT_V(8); PG8_WAIT_L(0); PG8_BAR; if (full) { PG8_MMA(1, 0, At, B0); PG8_MMA(1, 1, At, B1); } PG8_BAR; PG8_SCHED;
            PG8_LDB(B0, 1, 0); PG8_LDB(B1, 1, 1); PG8_SCHED; PG8_LDA(At, 1, 0); PG8_STAGE(PG8_SA(0, 1), a2, w10, w11);
            PG8_WAIT_V(8); PG8_WAIT_L(0); PG8_BAR; PG8_MMA(0, 0, At, B0); PG8_MMA(0, 1, At, B1); PG8_BAR; PG8_SCHED;
            if (full) { PG8_LDA(At, 1, 1); } PG8_STAGEB(PG8_SB(1, 0), b3); PG8_STAGEB(PG8_SB(1, 1), b3 + hstepB); PG8_STAGE(PG8_SA(1, 0), a3, w00, w01);
            PG8_WAIT_V(8); PG8_WAIT_L(0); PG8_BAR; if (full) { PG8_MMA(1, 0, At, B0); PG8_MMA(1, 1, At, B1); } PG8_BAR; PG8_SCHED;
        }
        if (wr == 0) PG8_BAR;
        if constexpr (FP8W != 0) asm volatile("s_nop 15\n\ts_nop 15" ::: "memory");
        run_epi(E, cur, acc, wr, wc, fr, fq);
        if (!has_next) break;
#pragma unroll
        for (int a = 0; a < 2; ++a)
#pragma unroll
            for (int b = 0; b < 2; ++b)
#pragma unroll
                for (int m = 0; m < 4; ++m)
#pragma unroll
                    for (int n = 0; n < 2; ++n) acc[a][b][m][n] = (f32x4){0.f, 0.f, 0.f, 0.f};
        cur = nxt; cA = nA; cB = nB; ++ui;
#pragma unroll
        for (int h = 0; h < 2; ++h)
#pragma unroll
            for (int i = 0; i < 2; ++i) vA[h][i] = vN[h][i];
        if (wr == 1) PG8_BAR;
    }
    PG8_WAIT_V(0);
    PG8_BAR;
#undef PG8_SA
#undef PG8_SB
#undef PG8_STAGE
#undef PG8_STAGEB
#undef PG8_LDA
#undef PG8_LDB
#undef PG8_MMA
#undef PG8_WAIT_V
#undef PG8_WAIT_L
#undef PG8_BAR
#undef PG8_SCHED
#undef PG8_VOFF
}
}
#ifndef OPT_GEMM
#define OPT_GEMM 1
#endif
template <bool GATHER, bool HALFSKIP = false, int FP8W = 0, int FP8A = 0, class Sched, class Epi>
__device__ __forceinline__ void gemm_run(Frame& F, const Sched& S, const Epi& E) {
#if OPT_GEMM
    pg8::gemm_phase<Sched, Epi, GATHER, HALFSKIP, FP8W, FP8A>(F.lds, S, E);
#else
    gemm_naive(S, E);
#endif
}

struct ThinArgs { const bf16* A[3]; const bf16* B[3]; };
template <int NSEG>
__device__ __forceinline__ void thin_dot8(const ThinArgs& t, int row, int c8, float (&acc)[8]) {
#pragma unroll
    for (int j = 0; j < 8; ++j) acc[j] = 0.f;
#pragma unroll
    for (int s = 0; s < NSEG; ++s) { const bf16* a = t.A[s] + (size_t)row * DM; const bf16* b = t.B[s] + (size_t)c8 * DM;
#pragma unroll 1
        for (int k = 0; k < DM; k += 8) { float av[8]; unpack8(*(const u32x4*)(a + k), av);
#pragma unroll
            for (int j = 0; j < 8; ++j) { float bv[8]; unpack8(*(const u32x4*)(b + (size_t)j * DM + k), bv);
#pragma unroll
                for (int q = 0; q < 8; ++q) acc[j] += av[q] * bv[q]; } } }
}
__device__ __forceinline__ void p3_kpe_naive(Frame& F) {
    ThinArgs t; t.A[0] = WSP(bf16, WS_H); t.B[0] = WSP(bf16, WS_WPE); t.A[1] = t.A[2] = t.A[0]; t.B[1] = t.B[2] = t.B[0];
    const f32x2* CS = WSP(f32x2, WS_ROPE); bf16* KPE = WSP(bf16, WS_KPE);
    for (int it = F.bid * NTHR + F.tid; it < NTOK * 4; it += F.G * NTHR) {
        const int row = it >> 2, c8 = (it & 3) * 8; float x1[8], x2[8];
        thin_dot8<1>(t, row, c8, x1); thin_dot8<1>(t, row, 32 + c8, x2);
        float o1[8], o2[8];
#pragma unroll
        for (int j = 0; j < 8; ++j) { const f32x2 cs = CS[(size_t)row * 32 + c8 + j]; o1[j] = x1[j] * cs.x - x2[j] * cs.y; o2[j] = x2[j] * cs.x + x1[j] * cs.y; }
        *(u32x4*)(KPE + (size_t)row * 64 + c8) = pack8(o1); *(u32x4*)(KPE + (size_t)row * 64 + 32 + c8) = pack8(o2);
    }
}

typedef float f32x4v __attribute__((ext_vector_type(4)));
template <bool ROUTER>
__device__ __forceinline__ void thin_mfma_partials(Frame& F, const bf16* A0, const bf16* A1, const bf16* B0, const bf16* B1, int m0, LAS float* red) {
    const int ru = F.wave & 1, kq4 = F.wave >> 1, r16 = F.lane & 15, kq = F.lane >> 4;
    f32x4 acc[4];
#pragma unroll
    for (int cb = 0; cb < 4; ++cb) acc[cb] = (f32x4){0.f, 0.f, 0.f, 0.f};
    const size_t aoff = (size_t)(m0 + 16 * ru + r16) * DM + 512 * kq4 + 8 * kq, boff = (size_t)r16 * DM + 512 * kq4 + 8 * kq;
    if constexpr (!ROUTER) {
#pragma unroll 1
        for (int kg = 0; kg < 16; kg += 2) { bf16x8 ahv[2], bhv[2][4];
#pragma unroll
            for (int q = 0; q < 2; ++q) { const int ks = kg + q; ahv[q] = *(const bf16x8*)(A0 + aoff + 32 * ks);
#pragma unroll
                for (int cb = 0; cb < 4; ++cb) bhv[q][cb] = *(const bf16x8*)(B0 + ((size_t)((kq4 * 16 + ks) * 4 + cb) * 64 + F.lane) * 8); }
            __builtin_amdgcn_sched_barrier(0);
#pragma unroll
            for (int q = 0; q < 2; ++q)
#pragma unroll
                for (int cb = 0; cb < 4; ++cb) acc[cb] = __builtin_amdgcn_mfma_f32_16x16x32_bf16(ahv[q], bhv[q][cb], acc[cb], 0, 0, 0);
            __builtin_amdgcn_sched_barrier(0); }
    } else
#pragma unroll 8
    for (int ks = 0; ks < 16; ++ks) {
        const bf16x8 ah = *(const bf16x8*)(A0 + aoff + 32 * ks);
        bf16x8 al; if (ROUTER) al = *(const bf16x8*)(A1 + aoff + 32 * ks);
#pragma unroll
        for (int cb = 0; cb < 4; ++cb) {
            const bf16x8 bh = ROUTER ? *(const bf16x8*)(B0 + boff + (size_t)cb * 16 * DM + 32 * ks) : *(const bf16x8*)(B0 + ((size_t)((kq4 * 16 + ks) * 4 + cb) * 64 + F.lane) * 8);
            acc[cb] = __builtin_amdgcn_mfma_f32_16x16x32_bf16(ah, bh, acc[cb], 0, 0, 0);
            if (ROUTER) { const bf16x8 bl = *(const bf16x8*)(B1 + boff + (size_t)cb * 16 * DM + 32 * ks);
                acc[cb] = __builtin_amdgcn_mfma_f32_16x16x32_bf16(al, bh, acc[cb], 0, 0, 0);
                acc[cb] = __builtin_amdgcn_mfma_f32_16x16x32_bf16(ah, bl, acc[cb], 0, 0, 0); }
        }
    }
#pragma unroll
    for (int cb = 0; cb < 4; ++cb)
#pragma unroll
        for (int rg = 0; rg < 4; ++rg) red[(F.wave * 16 + 4 * kq + rg) * 64 + cb * 16 + r16] = acc[cb][rg];
}
__device__ __forceinline__ f32x4 thin_reduce4(const LAS float* red, int row32, int c4) {
    const int ru = row32 >> 4, r = row32 & 15; f32x4 s = (f32x4){0.f, 0.f, 0.f, 0.f};
#pragma unroll
    for (int q = 0; q < 4; ++q) s += *(const LAS f32x4*)(red + ((q * 2 + ru) * 16 + r) * 64 + c4);
    return s;
}
__device__ __forceinline__ void p3_kpe_mfma(Frame& F) {
    LAS float* red = (LAS float*)F.lds; const f32x2* CS = WSP(f32x2, WS_ROPE); bf16* KPE = WSP(bf16, WS_KPE);
    for (int blk = F.bid; blk < NTOK / 32; blk += F.G) {
        const int m0 = blk * 32;
        const f32x4* csp = (const f32x4*)(CS + (size_t)(m0 + ((F.tid & 255) >> 3)) * 32 + (F.tid & 7) * 4); const f32x4 ct0 = csp[0], ct1 = csp[1];
        thin_mfma_partials<false>(F, WSP(bf16, WS_H), nullptr, WSP(bf16, WS_WPE), nullptr, m0, red);
        __syncthreads();
        if (F.tid < 256) { const int row32 = F.tid >> 3, c4 = (F.tid & 7) * 4, row = m0 + row32;
            const f32x4 x1 = thin_reduce4(red, row32, c4), x2 = thin_reduce4(red, row32, 32 + c4); float o1[4], o2[4];
            const float ccs[4] = {ct0.x, ct0.z, ct1.x, ct1.z}, csn[4] = {ct0.y, ct0.w, ct1.y, ct1.w};
#pragma unroll
            for (int j = 0; j < 4; ++j) { o1[j] = x1[j] * ccs[j] - x2[j] * csn[j]; o2[j] = x2[j] * ccs[j] + x1[j] * csn[j]; }
            *(u32x2*)(KPE + (size_t)row * 64 + c4) = (u32x2){pk2(o1[0], o1[1]), pk2(o1[2], o1[3])}; *(u32x2*)(KPE + (size_t)row * 64 + 32 + c4) = (u32x2){pk2(o2[0], o2[1]), pk2(o2[2], o2[3])}; }
        __syncthreads();
    }
}
#ifndef OPT_THIN
#define OPT_THIN 1
#endif

__device__ __forceinline__ void s5_pass1(Frame& F) {
    const bf16* U = WSP(bf16, WS_U); const f32x2* abar = WSP(f32x2, WS_S5P); const f32x2* bbar = abar + 8192; f32x2* E = WSP(f32x2, WS_S5E);
    LAS float* us = (LAS float*)(F.lds + F.wave * 4096);
    const int gw = F.bid * NWAVES + F.wave, NGW = F.G * NWAVES;
    for (int un = gw; un < NB * NCHUNK * S5G; un += NGW) {
        const int g = un % S5G, ch = (un / S5G) % NCHUNK, b = un / (S5G * NCHUNK); const int t0 = b * SEQ + ch * SCH;
        { const int t = F.lane; float f[8], f2[8]; unpack8(*(const u32x4*)(U + (size_t)(t0 + t) * S5CH + g * 16), f); unpack8(*(const u32x4*)(U + (size_t)(t0 + t) * S5CH + g * 16 + 8), f2);
#pragma unroll
          for (int j = 0; j < 8; ++j) { us[t * 16 + j] = f[j]; us[t * 16 + 8 + j] = f2[j]; } }
        LDS_WAIT();
        const int p = F.lane; const f32x2 a = abar[g * 64 + p]; float br[16], bi[16];
#pragma unroll
        for (int c = 0; c < 16; ++c) { const f32x2 t = bbar[(size_t)(g * 64 + p) * 16 + c]; br[c] = t.x; bi[c] = t.y; }
        float xr = 0.f, xi = 0.f;
#pragma unroll 1
        for (int t = 0; t < SCH; ++t) { float ur = 0.f, ui = 0.f;
#pragma unroll
            for (int c4 = 0; c4 < 4; ++c4) { const f32x4 uv = *(LAS f32x4*)(us + t * 16 + 4 * c4);
                ur += uv.x * br[4 * c4] + uv.y * br[4 * c4 + 1] + uv.z * br[4 * c4 + 2] + uv.w * br[4 * c4 + 3]; ui += uv.x * bi[4 * c4] + uv.y * bi[4 * c4 + 1] + uv.z * bi[4 * c4 + 2] + uv.w * bi[4 * c4 + 3]; }
            const float nr = a.x * xr - a.y * xi + ur, ni = a.x * xi + a.y * xr + ui; xr = nr; xi = ni; }
        E[((size_t)(b * NCHUNK + ch) * S5G + g) * 64 + p] = (f32x2){xr, xi};
        LDS_WAIT();
    }
}
__device__ __forceinline__ float gelu_tanh(float x) { const float u = 0.7978845608028654f * (x + 0.044715f * x * x * x); const float e = __expf(2.0f * u); const float th = 1.0f - 2.0f / (e + 1.0f); return 0.5f * x * (1.0f + th); }
__device__ __forceinline__ void s5_pass2(Frame& F) {
    const bf16* U = WSP(bf16, WS_U); const f32x2* abar = WSP(f32x2, WS_S5P); const f32x2* apow = abar + 4096; const f32x2* bbar = abar + 8192; const f32x2* E = WSP(f32x2, WS_S5E);
    const float* cre = INF(20); const float* cim = INF(21); const float* dsk = INF(22); bf16* YG = WSP(bf16, WS_YG);
    LAS float* us = (LAS float*)(F.lds + F.wave * 16384);
    LAS float* xs = us + 1024;
    const int gw = F.bid * NWAVES + F.wave, NGW = F.G * NWAVES;
    for (int un = gw; un < NB * NCHUNK * S5G; un += NGW) {
        const int g = un % S5G, ch = (un / S5G) % NCHUNK, b = un / (S5G * NCHUNK); const int t0 = b * SEQ + ch * SCH;
        { const int t = F.lane; float f[8], f2[8]; unpack8(*(const u32x4*)(U + (size_t)(t0 + t) * S5CH + g * 16), f); unpack8(*(const u32x4*)(U + (size_t)(t0 + t) * S5CH + g * 16 + 8), f2);
#pragma unroll
          for (int j = 0; j < 8; ++j) { us[t * 16 + j] = f[j]; us[t * 16 + 8 + j] = f2[j]; } }
        LDS_WAIT();
        const int p = F.lane; const f32x2 a = abar[g * 64 + p], aw = apow[g * 64 + p]; float br[16], bi[16];
#pragma unroll
        for (int c = 0; c < 16; ++c) { const f32x2 t = bbar[(size_t)(g * 64 + p) * 16 + c]; br[c] = t.x; bi[c] = t.y; }
        float xr = 0.f, xi = 0.f;
#pragma unroll 1
        for (int j = 0; j < ch; ++j) { const f32x2 e = E[((size_t)(b * NCHUNK + j) * S5G + g) * 64 + p]; const float nr = aw.x * xr - aw.y * xi + e.x, ni = aw.x * xi + aw.y * xr + e.y; xr = nr; xi = ni; }
        const int tt = F.lane >> 2, c4 = F.lane & 3;
#pragma unroll 1
        for (int sb = 0; sb < SCH / 16; ++sb) {
#pragma unroll 1
            for (int t = 0; t < 16; ++t) { const int tg = sb * 16 + t; float ur = 0.f, ui = 0.f;
#pragma unroll
                for (int q = 0; q < 4; ++q) { const f32x4 uv = *(LAS f32x4*)(us + tg * 16 + 4 * q);
                    ur += uv.x * br[4 * q] + uv.y * br[4 * q + 1] + uv.z * br[4 * q + 2] + uv.w * br[4 * q + 3]; ui += uv.x * bi[4 * q] + uv.y * bi[4 * q + 1] + uv.z * bi[4 * q + 2] + uv.w * bi[4 * q + 3]; }
                const float nr = a.x * xr - a.y * xi + ur, ni = a.x * xi + a.y * xr + ui; xr = nr; xi = ni;
                *(LAS f32x2*)(xs + (t * 64 + p) * 2) = (f32x2){xr, xi}; }
            LDS_WAIT();
            float y[4] = {0.f, 0.f, 0.f, 0.f};
#pragma unroll 1
            for (int q = 0; q < 64; ++q) { const f32x2 x = *(LAS f32x2*)(xs + (tt * 64 + q) * 2);
#pragma unroll
                for (int j = 0; j < 4; ++j) { const size_t ci = (size_t)(g * 16 + 4 * c4 + j) * 64 + q; y[j] += x.x * cre[ci] - x.y * cim[ci]; } }
            const int tg = sb * 16 + tt; float o[4];
#pragma unroll
            for (int j = 0; j < 4; ++j) { const int c = 4 * c4 + j; o[j] = gelu_tanh(y[j] + dsk[g * 16 + c] * us[tg * 16 + c]); }
            *(u32x2*)(YG + (size_t)(t0 + tg) * S5CH + g * 16 + 4 * c4) = (u32x2){pk2(o[0], o[1]), pk2(o[2], o[3])};
            LDS_WAIT();
        }
    }
}

__device__ __forceinline__ void s5_pass2_mfma(Frame& F) {
    const bf16* U = WSP(bf16, WS_U); const f32x2* abar = WSP(f32x2, WS_S5P); const f32x2* apow = abar + 4096; const f32x2* bbar = abar + 8192; const f32x2* E = WSP(f32x2, WS_S5E);
    const float* cre = INF(20); const float* cim = INF(21); const float* dsk = INF(22); bf16* YG = WSP(bf16, WS_YG);
    LAS float* us = (LAS float*)(F.lds + F.wave * 8704);
    LAS unsigned char* xs = (LAS unsigned char*)us + 4096;
    const int gw = F.bid * NWAVES + F.wave, NGW = F.G * NWAVES;
    const int c16 = F.lane & 15, kq = F.lane >> 4;
    for (int un = gw; un < NB * NCHUNK * S5G; un += NGW) {
        const int g = un % S5G, ch = (un / S5G) % NCHUNK, b = un / (S5G * NCHUNK); const int t0 = b * SEQ + ch * SCH;
        { const int t = F.lane; float f[8], f2[8]; unpack8(*(const u32x4*)(U + (size_t)(t0 + t) * S5CH + g * 16), f); unpack8(*(const u32x4*)(U + (size_t)(t0 + t) * S5CH + g * 16 + 8), f2);
#pragma unroll
          for (int j = 0; j < 8; ++j) { us[t * 16 + j] = f[j]; us[t * 16 + 8 + j] = f2[j]; } }
        const int p = F.lane; const f32x2 a = abar[g * 64 + p], aw = apow[g * 64 + p]; float br[16], bi[16];
#pragma unroll
        for (int c = 0; c < 16; ++c) { const f32x2 t = bbar[(size_t)(g * 64 + p) * 16 + c]; br[c] = t.x; bi[c] = t.y; }
        bf16x8 cf[4];
#pragma unroll
        for (int ks = 0; ks < 4; ++ks) { const int k0 = 32 * ks + 8 * kq; const float* src = (ks < 2) ? cre + (size_t)(g * 16 + c16) * 64 + k0 : cim + (size_t)(g * 16 + c16) * 64 + (k0 - 64);
            const f32x4 v0 = *(const f32x4*)src, v1 = *(const f32x4*)(src + 4); const float sg = (ks < 2) ? 1.f : -1.f;
            u32x4 w; w.x = pk2(sg * v0.x, sg * v0.y); w.y = pk2(sg * v0.z, sg * v0.w); w.z = pk2(sg * v1.x, sg * v1.y); w.w = pk2(sg * v1.z, sg * v1.w); cf[ks] = __builtin_bit_cast(bf16x8, w); }
        const float dk = dsk[g * 16 + c16];
        float xr = 0.f, xi = 0.f;
#pragma unroll 1
        for (int j = 0; j < ch; ++j) { const f32x2 e = E[((size_t)(b * NCHUNK + j) * S5G + g) * 64 + p]; const float nr = aw.x * xr - aw.y * xi + e.x, ni = aw.x * xi + aw.y * xr + e.y; xr = nr; xi = ni; }
        LDS_WAIT();
#pragma unroll 1
        for (int sb = 0; sb < SCH / 16; ++sb) {
#pragma unroll 4
            for (int t = 0; t < 16; ++t) { const int tg = sb * 16 + t; float ur = 0.f, ui = 0.f;
#pragma unroll
                for (int q = 0; q < 4; ++q) { const f32x4 uv = *(LAS f32x4*)(us + tg * 16 + 4 * q);
                    ur += uv.x * br[4 * q] + uv.y * br[4 * q + 1] + uv.z * br[4 * q + 2] + uv.w * br[4 * q + 3]; ui += uv.x * bi[4 * q] + uv.y * bi[4 * q + 1] + uv.z * bi[4 * q + 2] + uv.w * bi[4 * q + 3]; }
                const float nr = a.x * xr - a.y * xi + ur, ni = a.x * xi + a.y * xr + ui; xr = nr; xi = ni;
                *(LAS bf16*)(xs + t * 272 + p * 2) = (bf16)f2bf(xr); *(LAS bf16*)(xs + t * 272 + 128 + p * 2) = (bf16)f2bf(xi); }
            LDS_WAIT();
            f32x4 acc = (f32x4){0.f, 0.f, 0.f, 0.f};
#pragma unroll
            for (int ks = 0; ks < 4; ++ks) { const bf16x8 xa = *(const LAS bf16x8*)(xs + c16 * 272 + (32 * ks + 8 * kq) * 2); acc = __builtin_amdgcn_mfma_f32_16x16x32_bf16(xa, cf[ks], acc, 0, 0, 0); }
#pragma unroll
            for (int rg = 0; rg < 4; ++rg) { const int tg = sb * 16 + 4 * kq + rg; const float y = acc[rg] + dk * us[tg * 16 + c16];
                YG[(size_t)(t0 + tg) * S5CH + g * 16 + c16] = (bf16)f2bf(gelu_tanh(y)); }
            LDS_WAIT();
        }
    }
}
#ifndef OPT_S5
#define OPT_S5 1
#endif

template <bool PASS2>
__device__ __forceinline__ void s5_mfma(Frame& F) {
    const bf16* U = WSP(bf16, WS_U); const f32x2* abar = WSP(f32x2, WS_S5P); const f32x2* apow = abar + 4096; f32x2* E = WSP(f32x2, WS_S5E); const bf16* BBF = WSP(bf16, WS_S5BF);
    const float* cre = INF(20); const float* cim = INF(21); const float* dsk = INF(22); bf16* YG = WSP(bf16, WS_YG);
    LAS float* bu = (LAS float*)(F.lds + F.wave * 12800);
    LAS unsigned char* xs = (LAS unsigned char*)bu + 8448;
    const int gw = F.bid * NWAVES + F.wave, NGW = F.G * NWAVES;
    const int c16 = F.lane & 15, kq = F.lane >> 4, p = F.lane;
    for (int un = gw; un < NB * NCHUNK * S5G; un += NGW) {
        const int g = un % S5G, ch = (un / S5G) % NCHUNK, b = un / (S5G * NCHUNK); const int t0 = b * SEQ + ch * SCH;
        bf16x8 ua[4], bb[8];
#pragma unroll
        for (int tb = 0; tb < 4; ++tb) ua[tb] = *(const bf16x8*)(U + (size_t)(t0 + tb * 16 + c16) * S5CH + g * 16 + 8 * (kq & 1));
#pragma unroll
        for (int nb = 0; nb < 8; ++nb) bb[nb] = *(const bf16x8*)(BBF + ((size_t)(g * 8 + nb) * 64 + F.lane) * 8);
        const f32x2 a = abar[g * 64 + p];
        float xr = 0.f, xi = 0.f;
        bf16x8 cf[4]; float dk = 0.f;
        if (PASS2) {
            const f32x2 aw = apow[g * 64 + p];
#pragma unroll
            for (int ks = 0; ks < 4; ++ks) { const int k0 = 32 * ks + 8 * kq; const float* src = (ks < 2) ? cre + (size_t)(g * 16 + c16) * 64 + k0 : cim + (size_t)(g * 16 + c16) * 64 + (k0 - 64);
                const f32x4 v0 = *(const f32x4*)src, v1 = *(const f32x4*)(src + 4); const float sg = (ks < 2) ? 1.f : -1.f;
                u32x4 w; w.x = pk2(sg * v0.x, sg * v0.y); w.y = pk2(sg * v0.z, sg * v0.w); w.z = pk2(sg * v1.x, sg * v1.y); w.w = pk2(sg * v1.z, sg * v1.w); cf[ks] = __builtin_bit_cast(bf16x8, w); }
            dk = dsk[g * 16 + c16];
            f32x2 ev[NCHUNK - 1];
#pragma unroll
            for (int j = 0; j < NCHUNK - 1; ++j) ev[j] = (j < ch) ? E[((size_t)(b * NCHUNK + j) * S5G + g) * 64 + p] : (f32x2){0.f, 0.f};
#pragma unroll
            for (int j = 0; j < NCHUNK - 1; ++j) if (j < ch) { const float nr = aw.x * xr - aw.y * xi + ev[j].x, ni = aw.x * xi + aw.y * xr + ev[j].y; xr = nr; xi = ni; }
        }
#pragma unroll
        for (int tb = 0; tb < 4; ++tb) {
#pragma unroll
            for (int nb = 0; nb < 8; ++nb) { const f32x4 d = __builtin_amdgcn_mfma_f32_16x16x32_bf16(ua[tb], bb[nb], (f32x4){0.f, 0.f, 0.f, 0.f}, 0, 0, 0);
#pragma unroll
                for (int rg = 0; rg < 4; ++rg) bu[(4 * kq + rg) * 132 + 16 * nb + c16] = d[rg]; }
            LDS_WAIT();
#pragma unroll
            for (int t = 0; t < 16; ++t) { const float ur = bu[t * 132 + p], ui = bu[t * 132 + 64 + p];
                const float nr = a.x * xr - a.y * xi + ur, ni = a.x * xi + a.y * xr + ui; xr = nr; xi = ni;
                if (PASS2) { *(LAS bf16*)(xs + t * 272 + p * 2) = (bf16)f2bf(xr); *(LAS bf16*)(xs + t * 272 + 128 + p * 2) = (bf16)f2bf(xi); } }
            LDS_WAIT();
            if (PASS2) {
                f32x4 acc = (f32x4){0.f, 0.f, 0.f, 0.f};
#pragma unroll
                for (int ks = 0; ks < 4; ++ks) { const bf16x8 xa = *(const LAS bf16x8*)(xs + c16 * 272 + (32 * ks + 8 * kq) * 2); acc = __builtin_amdgcn_mfma_f32_16x16x32_bf16(xa, cf[ks], acc, 0, 0, 0); }
#pragma unroll
                for (int rg = 0; rg < 4; ++rg) { const size_t gi = (size_t)(t0 + tb * 16 + 4 * kq + rg) * S5CH + g * 16 + c16; const float y = acc[rg] + dk * bf2f(U[gi]); YG[gi] = (bf16)f2bf(gelu_tanh(y)); }
                LDS_WAIT();
            }
        }
        if (!PASS2) E[((size_t)(b * NCHUNK + ch) * S5G + g) * 64 + p] = (f32x2){xr, xi};
    }
}
#ifndef OPT_S5B
#define OPT_S5B 1
#endif

template <bool OUT>
__device__ __forceinline__ void s5_seg(const bf16* U, bf16* YG, LAS float* bu, LAS unsigned char* xs, const bf16x8 (&bb)[8], const bf16x8 (&cf)[4], f32x2 a, float dk, int t0, int g, int lane, float& xr, float& xi) {
    const int c16 = lane & 15, kq = lane >> 4, p = lane;
    bf16x8 ua[4], un[4];
#pragma unroll
    for (int tb = 0; tb < 4; ++tb) ua[tb] = *(const bf16x8*)(U + (size_t)(t0 + tb * 16 + c16) * S5CH + g * 16 + 8 * (kq & 1));
#pragma unroll 1
    for (int q4 = 0; q4 < 4; ++q4) {
        { const int qn = q4 < 3 ? q4 + 1 : q4;
#pragma unroll
          for (int tb = 0; tb < 4; ++tb) un[tb] = *(const bf16x8*)(U + (size_t)(t0 + qn * 64 + tb * 16 + c16) * S5CH + g * 16 + 8 * (kq & 1)); }
#pragma unroll
        for (int tb = 0; tb < 4; ++tb) {
            __builtin_amdgcn_sched_barrier(0);
            unsigned short usk[4];
            if (OUT) {
#pragma unroll
                for (int rg = 0; rg < 4; ++rg) usk[rg] = U[(size_t)(t0 + q4 * 64 + tb * 16 + 4 * kq + rg) * S5CH + g * 16 + c16]; }
#pragma unroll
            for (int nb = 0; nb < 8; ++nb) { const f32x4 d = __builtin_amdgcn_mfma_f32_16x16x32_bf16(ua[tb], bb[nb], (f32x4){0.f, 0.f, 0.f, 0.f}, 0, 0, 0);
#pragma unroll
                for (int rg = 0; rg < 4; ++rg) bu[(4 * kq + rg) * 132 + 16 * nb + c16] = d[rg]; }
            LDS_WAIT(); __builtin_amdgcn_sched_barrier(0);
#pragma unroll
            for (int t = 0; t < 16; ++t) { const float ur = bu[t * 132 + p], ui = bu[t * 132 + 64 + p];
                const float nr = a.x * xr - a.y * xi + ur, ni = a.x * xi + a.y * xr + ui; xr = nr; xi = ni;
                if (OUT) { *(LAS bf16*)(xs + t * 272 + p * 2) = (bf16)f2bf(xr); *(LAS bf16*)(xs + t * 272 + 128 + p * 2) = (bf16)f2bf(xi); } }
            LDS_WAIT(); __builtin_amdgcn_sched_barrier(0);
            if (OUT) {
                f32x4 acc = (f32x4){0.f, 0.f, 0.f, 0.f};
#pragma unroll
                for (int ks = 0; ks < 4; ++ks) { const bf16x8 xa = *(const LAS bf16x8*)(xs + c16 * 272 + (32 * ks + 8 * kq) * 2); acc = __builtin_amdgcn_mfma_f32_16x16x32_bf16(xa, cf[ks], acc, 0, 0, 0); }
#pragma unroll
                for (int rg = 0; rg < 4; ++rg) { const size_t gi = (size_t)(t0 + q4 * 64 + tb * 16 + 4 * kq + rg) * S5CH + g * 16 + c16; const float y = acc[rg] + dk * bf2f(usk[rg]); YG[gi] = (bf16)f2bf(gelu_tanh(y)); }
                LDS_WAIT();
            }
        }
#pragma unroll
        for (int tb = 0; tb < 4; ++tb) ua[tb] = un[tb];
    }
}
__device__ __forceinline__ void s5_fused(Frame& F) {
    const bf16* U = WSP(bf16, WS_U); const f32x2* abar = WSP(f32x2, WS_S5P); const f32x2* apow256 = abar + 73728; const bf16* BBF = WSP(bf16, WS_S5BF);
    const float* cre = INF(20); const float* cim = INF(21); const float* dsk = INF(22); bf16* YG = WSP(bf16, WS_YG);
    LAS float* bu = (LAS float*)(F.lds + F.wave * 12800);
    LAS unsigned char* xs = (LAS unsigned char*)bu + 8448;
    LAS f32x2* eend = (LAS f32x2*)(F.lds + 8 * 12800);
    const int c16 = F.lane & 15, kq = F.lane >> 4, p = F.lane;
    for (int pair = F.bid; pair < NB * S5G; pair += F.G) {
        const int b = pair >> 6, g = pair & 63; const int t0 = b * SEQ + F.wave * 256;
        bf16x8 bb[8];
#pragma unroll
        for (int nb = 0; nb < 8; ++nb) bb[nb] = *(const bf16x8*)(BBF + ((size_t)(g * 8 + nb) * 64 + F.lane) * 8);
        const f32x2 a = abar[g * 64 + p], aw = apow256[g * 64 + p];
        bf16x8 cf[4];
#pragma unroll
        for (int ks = 0; ks < 4; ++ks) { const int k0 = 32 * ks + 8 * kq; const float* src = (ks < 2) ? cre + (size_t)(g * 16 + c16) * 64 + k0 : cim + (size_t)(g * 16 + c16) * 64 + (k0 - 64);
            const f32x4 v0 = *(const f32x4*)src, v1 = *(const f32x4*)(src + 4); const float sg = (ks < 2) ? 1.f : -1.f;
            u32x4 w; w.x = pk2(sg * v0.x, sg * v0.y); w.y = pk2(sg * v0.z, sg * v0.w); w.z = pk2(sg * v1.x, sg * v1.y); w.w = pk2(sg * v1.z, sg * v1.w); cf[ks] = __builtin_bit_cast(bf16x8, w); }
        const float dk = dsk[g * 16 + c16];
        float xr = 0.f, xi = 0.f;
        s5_seg<false>(U, YG, bu, xs, bb, cf, a, dk, t0, g, F.lane, xr, xi);
        eend[F.wave * 64 + p] = (f32x2){xr, xi};
        __syncthreads();
        xr = 0.f; xi = 0.f;
        for (int w = 0; w < F.wave; ++w) { const f32x2 e = eend[w * 64 + p]; const float nr = aw.x * xr - aw.y * xi + e.x, ni = aw.x * xi + aw.y * xr + e.y; xr = nr; xi = ni; }
        s5_seg<true>(U, YG, bu, xs, bb, cf, a, dk, t0, g, F.lane, xr, xi);
        __syncthreads();
    }
}

__device__ __forceinline__ void attn_naive(Frame& F) {
    const bf16* Q = WSP(bf16, WS_Q); const bf16* KN = WSP(bf16, WS_KN); const bf16* KPE = WSP(bf16, WS_KPE); const bf16* VT = WSP(bf16, WS_VT); bf16* AO = WSP(bf16, WS_AO);
    const int* pos = (const int*)F.in[2]; const int* tc = WSP(int, WS_TILEC);
    LAS float* ps = (LAS float*)(F.lds + F.wave * 9216);
    LAS float* qs = ps + 2048;
    const int gw = F.bid * NWAVES + F.wave, NGW = F.G * NWAVES;
    for (int un = gw; un < NTOK * NH; un += NGW) {
        const int h = un % NH, m = un / NH, b = m / SEQ; const int qc = pos[m] >> 6;
        for (int i = F.lane; i < DQK; i += 64) qs[i] = bf2f(Q[(size_t)m * 1536 + h * DQK + i]);
        LDS_WAIT();
        float mx = -3.0e38f;
#pragma unroll 1
        for (int kt = 0; kt < 32; ++kt) {
            const int key = b * SEQ + kt * 64 + F.lane; float s = -1.0e30f;
            if (tc[b * 32 + kt] <= qc) {
                float acc = 0.f;
#pragma unroll 1
                for (int f8 = 0; f8 < 16; ++f8) { float kv[8]; unpack8(*(const u32x4*)(KN + (size_t)key * 1024 + h * 128 + f8 * 8), kv);
#pragma unroll
                    for (int j = 0; j < 8; ++j) acc += kv[j] * qs[f8 * 8 + j]; }
#pragma unroll 1
                for (int f8 = 0; f8 < 8; ++f8) { float kv[8]; unpack8(*(const u32x4*)(KPE + (size_t)key * 64 + f8 * 8), kv);
#pragma unroll
                    for (int j = 0; j < 8; ++j) acc += kv[j] * qs[128 + f8 * 8 + j]; }
                if ((pos[key] >> 6) <= qc) s = acc;
            }
            ps[kt * 64 + F.lane] = s; mx = fmaxf(mx, s);
        }
#pragma unroll
        for (int o = 1; o < 64; o <<= 1) mx = fmaxf(mx, __shfl_xor(mx, o));
        float sum = 0.f;
#pragma unroll 1
        for (int kt = 0; kt < 32; ++kt) { const float p = exp2f(ps[kt * 64 + F.lane] - mx); sum += p; ps[kt * 64 + F.lane] = bf2f(f2bf(p)); }
        sum = wave_sum(sum);
        LDS_WAIT();
        float o0 = 0.f, o1 = 0.f;
        const bf16* v0 = VT + (size_t)(h * 128 + F.lane) * NTOK + b * SEQ; const bf16* v1 = v0 + (size_t)64 * NTOK;
#pragma unroll 1
        for (int k8 = 0; k8 < SEQ / 8; ++k8) { float a[8], c[8]; unpack8(*(const u32x4*)(v0 + k8 * 8), a); unpack8(*(const u32x4*)(v1 + k8 * 8), c);
#pragma unroll
            for (int j = 0; j < 8; ++j) { const float p = ps[k8 * 8 + j]; o0 += p * a[j]; o1 += p * c[j]; } }
        const float inv = 1.0f / sum;
        AO[(size_t)m * 1024 + h * 128 + F.lane] = (bf16)f2bf(o0 * inv); AO[(size_t)m * 1024 + h * 128 + 64 + F.lane] = (bf16)f2bf(o1 * inv);
        LDS_WAIT();
    }
}

namespace att {
typedef float f32x16 __attribute__((ext_vector_type(16)));
typedef short s16x4 __attribute__((ext_vector_type(4)));
constexpr int KROW = 400, VROW = 136, KT_BYTES = 64 * KROW, VT_BYTES = 128 * VROW, KC_BYTES = 256, BUF_BYTES = KT_BYTES + VT_BYTES + KC_BYTES;
__device__ __forceinline__ unsigned cvtpk(float lo, float hi) { unsigned r; asm volatile("v_cvt_pk_bf16_f32 %0, %1, %2" : "=v"(r) : "v"(lo), "v"(hi)); return r; }
struct Stage { u32x4 r0, r1, r2, r3, r4; int kc; };
__device__ __forceinline__ void issue(Stage& st, const bf16* KN, const bf16* KPE, const bf16* VT, const int* pos, int tok0, int h, int tid) {
    st.r0 = *(const u32x4*)(KN + (size_t)(tok0 + (tid >> 4)) * 1024 + h * 128 + (tid & 15) * 8);
    st.r1 = *(const u32x4*)(KN + (size_t)(tok0 + 32 + (tid >> 4)) * 1024 + h * 128 + (tid & 15) * 8);
    st.r2 = *(const u32x4*)(KPE + (size_t)(tok0 + (tid >> 3)) * 64 + (tid & 7) * 8);
    st.r3 = *(const u32x4*)(VT + (size_t)(h * 128 + (tid >> 3)) * NTOK + tok0 + (tid & 7) * 8);
    st.r4 = *(const u32x4*)(VT + (size_t)(h * 128 + 64 + (tid >> 3)) * NTOK + tok0 + (tid & 7) * 8);
    st.kc = (tid < 64) ? (pos[tok0 + tid] >> 6) : 0;
}
__device__ __forceinline__ void commit(const Stage& st, LAS unsigned char* buf, int tid) {
    *(LAS u32x4*)(buf + (tid >> 4) * KROW + (tid & 15) * 16) = st.r0;
    *(LAS u32x4*)(buf + (32 + (tid >> 4)) * KROW + (tid & 15) * 16) = st.r1;
    *(LAS u32x4*)(buf + (tid >> 3) * KROW + 256 + (tid & 7) * 16) = st.r2;
    LAS unsigned char* vb = buf + KT_BYTES;
    *(LAS u32x2*)(vb + (tid >> 3) * VROW + (tid & 7) * 16) = (u32x2){st.r3.x, st.r3.y}; *(LAS u32x2*)(vb + (tid >> 3) * VROW + (tid & 7) * 16 + 8) = (u32x2){st.r3.z, st.r3.w};
    *(LAS u32x2*)(vb + (64 + (tid >> 3)) * VROW + (tid & 7) * 16) = (u32x2){st.r4.x, st.r4.y}; *(LAS u32x2*)(vb + (64 + (tid >> 3)) * VROW + (tid & 7) * 16 + 8) = (u32x2){st.r4.z, st.r4.w};
    if (tid < 64) *(LAS int*)(buf + KT_BYTES + VT_BYTES + tid * 4) = st.kc;
}
__device__ __forceinline__ void attn_phase(Frame& F) {
    const bf16* Q = WSP(bf16, WS_Q); const bf16* KN = WSP(bf16, WS_KN); const bf16* KPE = WSP(bf16, WS_KPE); const bf16* VT = WSP(bf16, WS_VT); bf16* AO = WSP(bf16, WS_AO);
    const int* pos = (const int*)F.in[2]; const int* tc = WSP(int, WS_TILEC);
    const int tid = F.tid, lane = F.lane, hh = lane >> 5, ql = lane & 31, half = F.wave >> 2, wq = F.wave & 3;
    for (int unit = F.bid; unit < NB * NH * 8; unit += F.G) {
        const int j = unit & 7, bh = unit >> 3, b = bh >> 3, h = bh & 7;
        const int qblk = half ? (15 - j) : j;
        const int qrow = b * SEQ + qblk * 128 + wq * 32 + ql;
        bf16x8 qf[12];
#pragma unroll
        for (int ks = 0; ks < 12; ++ks) qf[ks] = *(const bf16x8*)(Q + (size_t)qrow * 1536 + h * DQK + 16 * ks + 8 * hh);
        const int qc = pos[qrow] >> 6;
        int qcmin = qc;
#pragma unroll
        for (int o = 1; o < 32; o <<= 1) { const int t = __shfl_xor(qcmin, o); qcmin = t < qcmin ? t : qcmin; }
        qcmin = __builtin_amdgcn_readfirstlane(qcmin);
        const int tmm = (lane < 32) ? tc[b * 32 + lane] : tc[128 + b * 32 + (lane - 32)];
#define TMIN(k) __builtin_amdgcn_readlane(tmm, (k))
#define TMAX(k) __builtin_amdgcn_readlane(tmm, 32 + (k))
        const int qmA0 = TMAX(2 * j), qmA1 = TMAX(2 * j + 1), qmB0 = TMAX(2 * (15 - j)), qmB1 = TMAX(2 * (15 - j) + 1);
        const int qmaxA = qmA0 > qmA1 ? qmA0 : qmA1, qmaxB = qmB0 > qmB1 ? qmB0 : qmB1;
        const int myqmax = half ? qmaxB : qmaxA, anyqmax = qmaxA > qmaxB ? qmaxA : qmaxB;
        f32x16 O[4];
#pragma unroll
        for (int d = 0; d < 4; ++d)
#pragma unroll
            for (int r = 0; r < 16; ++r) O[d][r] = 0.f;
        float m = -1.0e30f, l = 0.f;
        int kt = 0; while (kt < 32 && TMIN(kt) > anyqmax) ++kt;
        Stage st;
        if (kt < 32) { issue(st, KN, KPE, VT, pos, b * SEQ + kt * 64, h, tid); commit(st, F.lds, tid); }
        __syncthreads();
        int bufi = 0;
        while (kt < 32) {
            int ktn = kt + 1; while (ktn < 32 && TMIN(ktn) > anyqmax) ++ktn;
            if (ktn < 32) issue(st, KN, KPE, VT, pos, b * SEQ + ktn * 64, h, tid);
            if (TMIN(kt) <= myqmax) {
                const LAS unsigned char* kb_ = F.lds + bufi * BUF_BYTES; const LAS unsigned char* vb_ = kb_ + KT_BYTES; const LAS unsigned char* kcb = vb_ + VT_BYTES;
                f32x16 S0, S1;
#pragma unroll
                for (int r = 0; r < 16; ++r) { S0[r] = 0.f; S1[r] = 0.f; }
#pragma unroll
                for (int ks = 0; ks < 12; ++ks) {
                    const bf16x8 k0 = *(const LAS bf16x8*)(kb_ + ql * KROW + (16 * ks + 8 * hh) * 2);
                    const bf16x8 k1 = *(const LAS bf16x8*)(kb_ + (32 + ql) * KROW + (16 * ks + 8 * hh) * 2);
                    S0 = __builtin_amdgcn_mfma_f32_32x32x16_bf16(k0, qf[ks], S0, 0, 0, 0);
                    S1 = __builtin_amdgcn_mfma_f32_32x32x16_bf16(k1, qf[ks], S1, 0, 0, 0);
                }
                if (TMAX(kt) > qcmin) {
#pragma unroll
                    for (int g = 0; g < 4; ++g) {
                        const u32x4 c0 = *(const LAS u32x4*)(kcb + (8 * g + 4 * hh) * 4), c1 = *(const LAS u32x4*)(kcb + (32 + 8 * g + 4 * hh) * 4);
#pragma unroll
                        for (int i = 0; i < 4; ++i) { if ((int)c0[i] > qc) S0[4 * g + i] = -1.0e30f; if ((int)c1[i] > qc) S1[4 * g + i] = -1.0e30f; }
                    }
                }
                float mx = S0[0];
#pragma unroll
                for (int r = 1; r < 16; ++r) mx = fmaxf(mx, S0[r]);
#pragma unroll
                for (int r = 0; r < 16; ++r) mx = fmaxf(mx, S1[r]);
                mx = fmaxf(mx, __shfl_xor(mx, 32));
                const float mn = fmaxf(m, mx), alpha = __builtin_amdgcn_exp2f(m - mn); m = mn;
                float ps = 0.f;
#pragma unroll
                for (int r = 0; r < 16; ++r) { S0[r] = __builtin_amdgcn_exp2f(S0[r] - mn); S1[r] = __builtin_amdgcn_exp2f(S1[r] - mn); ps += S0[r] + S1[r]; }
                l = l * alpha + ps;
                if (__any(alpha != 1.0f)) {
#pragma unroll
                    for (int d = 0; d < 4; ++d)
#pragma unroll
                        for (int r = 0; r < 16; ++r) O[d][r] *= alpha;
                }
                bf16x8 pf[2][2];
#pragma unroll
                for (int s2 = 0; s2 < 2; ++s2) {
                    u32x4 w0, w1;
                    w0.x = cvtpk(S0[8 * s2 + 0], S0[8 * s2 + 1]); w0.y = cvtpk(S0[8 * s2 + 2], S0[8 * s2 + 3]); w0.z = cvtpk(S0[8 * s2 + 4], S0[8 * s2 + 5]); w0.w = cvtpk(S0[8 * s2 + 6], S0[8 * s2 + 7]);
                    w1.x = cvtpk(S1[8 * s2 + 0], S1[8 * s2 + 1]); w1.y = cvtpk(S1[8 * s2 + 2], S1[8 * s2 + 3]); w1.z = cvtpk(S1[8 * s2 + 4], S1[8 * s2 + 5]); w1.w = cvtpk(S1[8 * s2 + 6], S1[8 * s2 + 7]);
                    pf[0][s2] = __builtin_bit_cast(bf16x8, w0); pf[1][s2] = __builtin_bit_cast(bf16x8, w1);
                }
#pragma unroll
                for (int db = 0; db < 4; ++db)
#pragma unroll
                    for (int kb = 0; kb < 2; ++kb)
#pragma unroll
                        for (int s2 = 0; s2 < 2; ++s2) {
                            const LAS unsigned char* vp = vb_ + (32 * db + ql) * VROW + (32 * kb + 16 * s2 + 4 * hh) * 2;
                            const s16x4 lo = *(const LAS s16x4*)vp, hi = *(const LAS s16x4*)(vp + 16);
                            const bf16x8 a = __builtin_shufflevector(lo, hi, 0, 1, 2, 3, 4, 5, 6, 7);
                            O[db] = __builtin_amdgcn_mfma_f32_32x32x16_bf16(a, pf[kb][s2], O[db], 0, 0, 0);
                        }
            }
            if (ktn < 32) commit(st, F.lds + (bufi ^ 1) * BUF_BYTES, tid);
            __syncthreads();
            kt = ktn; bufi ^= 1;
        }
        l += __shfl_xor(l, 32);
        const float inv = 1.0f / l;
        bf16* op = AO + (size_t)qrow * 1024 + h * 128;
#pragma unroll
        for (int db = 0; db < 4; ++db)
#pragma unroll
            for (int g = 0; g < 4; ++g) {
                const int d0 = 32 * db + 8 * g + 4 * hh;
                *(u32x2*)(op + d0) = (u32x2){pk2(O[db][4 * g] * inv, O[db][4 * g + 1] * inv), pk2(O[db][4 * g + 2] * inv, O[db][4 * g + 3] * inv)};
            }
    }
}
}
namespace att3 {
using att::f32x16; using att::s16x4; using att::cvtpk; using att::Stage; using att::issue; using att::commit;
using att::KROW; using att::VROW; using att::KT_BYTES; using att::VT_BYTES; using att::BUF_BYTES;
__device__ __forceinline__ void store_rows(bf16* AO, int qrow, int h, int hh, const f32x16 (&O)[4], float l) {
    l += __shfl_xor(l, 32);
    const float inv = 1.0f / l;
    bf16* op = AO + (size_t)qrow * 1024 + h * 128;
#pragma unroll
    for (int db = 0; db < 4; ++db)
#pragma unroll
        for (int g = 0; g < 4; ++g) { const int d0 = 32 * db + 8 * g + 4 * hh;
            *(u32x2*)(op + d0) = (u32x2){pk2(O[db][4 * g] * inv, O[db][4 * g + 1] * inv), pk2(O[db][4 * g + 2] * inv, O[db][4 * g + 3] * inv)}; }
}
__device__ __forceinline__ void attn_phase(Frame& F) {
    const bf16* Q = WSP(bf16, WS_Q); const bf16* KN = WSP(bf16, WS_KN); const bf16* KPE = WSP(bf16, WS_KPE); const bf16* VT = WSP(bf16, WS_VT); bf16* AO = WSP(bf16, WS_AO);
    const int* pos = (const int*)F.in[2]; const int* tc = WSP(int, WS_TILEC);
    const int tid = F.tid, lane = F.lane, hh = lane >> 5, ql = lane & 31, half = F.wave >> 2, wq = F.wave & 3;
    for (int unit = F.bid; unit < NB * NH * 8; unit += F.G) {
        const int j = unit & 7, bh = unit >> 3, b = bh >> 3, h = bh & 7;
        const int qrowH = b * SEQ + (15 - j) * 128 + wq * 32 + ql;
        int qrow = half ? qrowH : b * SEQ + j * 128 + wq * 32 + ql;
        bf16x8 qf[12];
#pragma unroll
        for (int ks = 0; ks < 12; ++ks) qf[ks] = *(const bf16x8*)(Q + (size_t)qrow * 1536 + h * DQK + 16 * ks + 8 * hh);
        int qc = pos[qrow] >> 6;
        int qcmin = qc;
#pragma unroll
        for (int o = 1; o < 32; o <<= 1) { const int t = __shfl_xor(qcmin, o); qcmin = t < qcmin ? t : qcmin; }
        qcmin = __builtin_amdgcn_readfirstlane(qcmin);
        const int tmm = (lane < 32) ? tc[b * 32 + lane] : tc[128 + b * 32 + (lane - 32)];
        const int qmA0 = TMAX(2 * j), qmA1 = TMAX(2 * j + 1), qmB0 = TMAX(2 * (15 - j)), qmB1 = TMAX(2 * (15 - j) + 1);
        const int qmaxA = qmA0 > qmA1 ? qmA0 : qmA1, qmaxB = qmB0 > qmB1 ? qmB0 : qmB1;
        const int anyqmax = qmaxA > qmaxB ? qmaxA : qmaxB;
        int lastA = -1;
#pragma unroll 1
        for (int k = 0; k < 32; ++k) if (TMIN(k) <= qmaxA) lastA = k;
        f32x16 O[4];
#pragma unroll
        for (int d = 0; d < 4; ++d)
#pragma unroll
            for (int r = 0; r < 16; ++r) O[d][r] = 0.f;
        float m = -1.0e30f, l = 0.f;
        int kt = 0; while (kt < 32 && TMIN(kt) > anyqmax) ++kt;
        Stage st;
        if (kt < 32) { issue(st, KN, KPE, VT, pos, b * SEQ + kt * 64, h, tid); commit(st, F.lds, tid); }
        __syncthreads();
        int bufi = 0;
        while (kt < 32 && kt <= lastA) {
            int ktn = kt + 1; while (ktn < 32 && TMIN(ktn) > anyqmax) ++ktn;
            if (ktn < 32) issue(st, KN, KPE, VT, pos, b * SEQ + ktn * 64, h, tid);
            const LAS unsigned char* kb_ = F.lds + bufi * BUF_BYTES; const LAS unsigned char* vb_ = kb_ + KT_BYTES; const LAS unsigned char* kcb = vb_ + VT_BYTES;
            if (TMIN(kt) <= (half ? qmaxB : qmaxA)) {
                f32x16 S0, S1;
#pragma unroll
                for (int r = 0; r < 16; ++r) { S0[r] = 0.f; S1[r] = 0.f; }
#pragma unroll
                for (int ks = 0; ks < 12; ++ks) {
                    const bf16x8 k0 = *(const LAS bf16x8*)(kb_ + ql * KROW + (16 * ks + 8 * hh) * 2);
                    const bf16x8 k1 = *(const LAS bf16x8*)(kb_ + (32 + ql) * KROW + (16 * ks + 8 * hh) * 2);
                    S0 = __builtin_amdgcn_mfma_f32_32x32x16_bf16(k0, qf[ks], S0, 0, 0, 0);
                    S1 = __builtin_amdgcn_mfma_f32_32x32x16_bf16(k1, qf[ks], S1, 0, 0, 0);
                }
                if (TMAX(kt) > qcmin) {
#pragma unroll
                    for (int g = 0; g < 4; ++g) {
                        const u32x4 c0 = *(const LAS u32x4*)(kcb + (8 * g + 4 * hh) * 4), c1 = *(const LAS u32x4*)(kcb + (32 + 8 * g + 4 * hh) * 4);
#pragma unroll
                        for (int i = 0; i < 4; ++i) { if ((int)c0[i] > qc) S0[4 * g + i] = -1.0e30f; if ((int)c1[i] > qc) S1[4 * g + i] = -1.0e30f; }
                    }
                }
                float mx = S0[0];
#pragma unroll
                for (int r = 1; r < 16; ++r) mx = fmaxf(mx, S0[r]);
#pragma unroll
                for (int r = 0; r < 16; ++r) mx = fmaxf(mx, S1[r]);
                mx = fmaxf(mx, __shfl_xor(mx, 32));
                const float mn = fmaxf(m, mx), alpha = __builtin_amdgcn_exp2f(m - mn); m = mn;
                float ps = 0.f;
#pragma unroll
                for (int r = 0; r < 16; ++r) { S0[r] = __builtin_amdgcn_exp2f(S0[r] - mn); S1[r] = __builtin_amdgcn_exp2f(S1[r] - mn); ps += S0[r] + S1[r]; }
                l = l * alpha + ps;
                if (__any(alpha != 1.0f)) {
#pragma unroll
                    for (int d = 0; d < 4; ++d)
#pragma unroll
                        for (int r = 0; r < 16; ++r) O[d][r] *= alpha;
                }
                bf16x8 pf[2][2];
#pragma unroll
                for (int s2 = 0; s2 < 2; ++s2) {
                    u32x4 w0, w1;
                    w0.x = cvtpk(S0[8 * s2 + 0], S0[8 * s2 + 1]); w0.y = cvtpk(S0[8 * s2 + 2], S0[8 * s2 + 3]); w0.z = cvtpk(S0[8 * s2 + 4], S0[8 * s2 + 5]); w0.w = cvtpk(S0[8 * s2 + 6], S0[8 * s2 + 7]);
                    w1.x = cvtpk(S1[8 * s2 + 0], S1[8 * s2 + 1]); w1.y = cvtpk(S1[8 * s2 + 2], S1[8 * s2 + 3]); w1.z = cvtpk(S1[8 * s2 + 4], S1[8 * s2 + 5]); w1.w = cvtpk(S1[8 * s2 + 6], S1[8 * s2 + 7]);
                    pf[0][s2] = __builtin_bit_cast(bf16x8, w0); pf[1][s2] = __builtin_bit_cast(bf16x8, w1);
                }
#pragma unroll
                for (int kb = 0; kb < 2; ++kb)
#pragma unroll
                    for (int s2 = 0; s2 < 2; ++s2)
#pragma unroll
                        for (int db = 0; db < 4; ++db) {
                            const LAS unsigned char* vp = vb_ + (32 * db + ql) * VROW + (32 * kb + 16 * s2 + 4 * hh) * 2;
                            const s16x4 lo = *(const LAS s16x4*)vp, hi = *(const LAS s16x4*)(vp + 16);
                            const bf16x8 a = __builtin_shufflevector(lo, hi, 0, 1, 2, 3, 4, 5, 6, 7);
                            O[db] = __builtin_amdgcn_mfma_f32_32x32x16_bf16(a, pf[kb][s2], O[db], 0, 0, 0);
                        }
            }
            if (ktn < 32) commit(st, F.lds + (bufi ^ 1) * BUF_BYTES, tid);
            __syncthreads();
            kt = ktn; bufi ^= 1;
        }
        if (half == 0) {
            store_rows(AO, qrow, h, hh, O, l);
            qrow = qrowH;
#pragma unroll
            for (int ks = 0; ks < 12; ++ks) qf[ks] = *(const bf16x8*)(Q + (size_t)qrow * 1536 + h * DQK + 16 * ks + 8 * hh);
            qc = pos[qrow] >> 6; qcmin = qc;
#pragma unroll
            for (int o = 1; o < 32; o <<= 1) { const int t = __shfl_xor(qcmin, o); qcmin = t < qcmin ? t : qcmin; }
            qcmin = __builtin_amdgcn_readfirstlane(qcmin);
#pragma unroll
            for (int d = 0; d < 4; ++d)
#pragma unroll
                for (int r = 0; r < 16; ++r) O[d][r] = 0.f;
            m = -1.0e30f; l = 0.f;
        }
        while (kt < 32) {
            int ktn = kt + 1; while (ktn < 32 && TMIN(ktn) > anyqmax) ++ktn;
            if (ktn < 32) issue(st, KN, KPE, VT, pos, b * SEQ + ktn * 64, h, tid);
            const LAS unsigned char* kb_ = F.lds + bufi * BUF_BYTES; const LAS unsigned char* vb_ = kb_ + KT_BYTES; const LAS unsigned char* kcb = vb_ + VT_BYTES;
            if (TMIN(kt) <= qmaxB) {
                const int kb = half;
                f32x16 S0;
#pragma unroll
                for (int r = 0; r < 16; ++r) S0[r] = 0.f;
#pragma unroll
                for (int ks = 0; ks < 12; ++ks) {
                    const bf16x8 k0 = *(const LAS bf16x8*)(kb_ + (32 * kb + ql) * KROW + (16 * ks + 8 * hh) * 2);
                    S0 = __builtin_amdgcn_mfma_f32_32x32x16_bf16(k0, qf[ks], S0, 0, 0, 0);
                }
                if (TMAX(kt) > qcmin) {
#pragma unroll
                    for (int g = 0; g < 4; ++g) { const u32x4 c0 = *(const LAS u32x4*)(kcb + (32 * kb + 8 * g + 4 * hh) * 4);
#pragma unroll
                        for (int i = 0; i < 4; ++i) if ((int)c0[i] > qc) S0[4 * g + i] = -1.0e30f; }
                }
                float mx = S0[0];
#pragma unroll
                for (int r = 1; r < 16; ++r) mx = fmaxf(mx, S0[r]);
                mx = fmaxf(mx, __shfl_xor(mx, 32));
                const float mn = fmaxf(m, mx), alpha = __builtin_amdgcn_exp2f(m - mn); m = mn;
                float ps = 0.f;
#pragma unroll
                for (int r = 0; r < 16; ++r) { S0[r] = __builtin_amdgcn_exp2f(S0[r] - mn); ps += S0[r]; }
                l = l * alpha + ps;
                if (__any(alpha != 1.0f)) {
#pragma unroll
                    for (int d = 0; d < 4; ++d)
#pragma unroll
                        for (int r = 0; r < 16; ++r) O[d][r] *= alpha;
                }
                bf16x8 pf[2];
#pragma unroll
                for (int s2 = 0; s2 < 2; ++s2) { u32x4 w0;
                    w0.x = cvtpk(S0[8 * s2 + 0], S0[8 * s2 + 1]); w0.y = cvtpk(S0[8 * s2 + 2], S0[8 * s2 + 3]); w0.z = cvtpk(S0[8 * s2 + 4], S0[8 * s2 + 5]); w0.w = cvtpk(S0[8 * s2 + 6], S0[8 * s2 + 7]);
                    pf[s2] = __builtin_bit_cast(bf16x8, w0); }
#pragma unroll
                for (int s2 = 0; s2 < 2; ++s2)
#pragma unroll
                    for (int db = 0; db < 4; ++db) {
                        const LAS unsigned char* vp = vb_ + (32 * db + ql) * VROW + (32 * kb + 16 * s2 + 4 * hh) * 2;
                        const s16x4 lo = *(const LAS s16x4*)vp, hi = *(const LAS s16x4*)(vp + 16);
                        const bf16x8 a = __builtin_shufflevector(lo, hi, 0, 1, 2, 3, 4, 5, 6, 7);
                        O[db] = __builtin_amdgcn_mfma_f32_32x32x16_bf16(a, pf[s2], O[db], 0, 0, 0);
                    }
            }
            if (ktn < 32) commit(st, F.lds + (bufi ^ 1) * BUF_BYTES, tid);
            __syncthreads();
            kt = ktn; bufi ^= 1;
        }
        LAS float* xb = (LAS float*)F.lds + wq * (66 * 64);
        if (half == 0) {
#pragma unroll
            for (int d = 0; d < 4; ++d)
#pragma unroll
                for (int r = 0; r < 16; ++r) xb[(16 * d + r) * 64 + lane] = O[d][r];
            xb[64 * 64 + lane] = m; xb[65 * 64 + lane] = l;
        }
        __syncthreads();
        if (half == 1) {
            const float m2 = xb[64 * 64 + lane], l2 = xb[65 * 64 + lane];
            const float mn = fmaxf(m, m2), a1 = __builtin_amdgcn_exp2f(m - mn), a2 = __builtin_amdgcn_exp2f(m2 - mn);
#pragma unroll
            for (int d = 0; d < 4; ++d)
#pragma unroll
                for (int r = 0; r < 16; ++r) O[d][r] = O[d][r] * a1 + xb[(16 * d + r) * 64 + lane] * a2;
            l = l * a1 + l2 * a2;
            store_rows(AO, qrowH, h, hh, O, l);
        }
        __syncthreads();
    }
}
}
#ifndef OPT_ATTN
#define OPT_ATTN 1
#endif

template <bool BLK> __device__ __forceinline__ void p8_tok(Frame& F, int m0) {
    const int gw = F.bid * NWAVES + F.wave, NGW = F.G * NWAVES;
    const float* x = INF(0); const float* gpost = INF(6); const float* gpre = INF(7); const float* mod = WSP(float, WS_MOD); const bf16* MX = WSP(bf16, WS_MIXED);
    bf16* H = WSP(bf16, WS_H); bf16* HL = WSP(bf16, WS_H2LO);
    for (int m = BLK ? m0 + F.wave * 4 : gw; m < (BLK ? m0 + F.wave * 4 + 4 : NTOK); m += (BLK ? 1 : NGW)) {
        const int b = m / SEQ; const u32x2* mr = (const u32x2*)(MX + (size_t)m * DM) + F.lane; const f32x4* xr = (const f32x4*)(x + (size_t)m * DM) + F.lane;
        f32x4 v[8]; float s = 0.f;
#pragma unroll
        for (int j = 0; j < 8; ++j) { const u32x2 w = mr[64 * j]; v[j] = (f32x4){__uint_as_float(w.x << 16), __uint_as_float(w.x & 0xffff0000u), __uint_as_float(w.y << 16), __uint_as_float(w.y & 0xffff0000u)}; s += (v[j].x * v[j].x + v[j].y * v[j].y) + (v[j].z * v[j].z + v[j].w * v[j].w); }
        const float rs = 1.0f / sqrtf(wave_sum(s) * (1.0f / DM) + EPS);
        const float* mb = mod + b * 12288; float s2 = 0.f;
        f32x4* xo = (f32x4*)(F.out + (size_t)m * DM) + F.lane;
#pragma unroll
        for (int j = 0; j < 8; ++j) { const int k = 4 * F.lane + 256 * j; const f32x4 gg = *(const f32x4*)(gpost + k), gt = *(const f32x4*)(mb + 2 * DM + k);
            v[j] = xr[64 * j] + gt * (v[j] * rs * gg); xo[64 * j] = v[j]; s2 += (v[j].x * v[j].x + v[j].y * v[j].y) + (v[j].z * v[j].z + v[j].w * v[j].w); }
        const float rs2 = 1.0f / sqrtf(wave_sum(s2) * (1.0f / DM) + EPS);
        u32x2* oh = (u32x2*)(H + (size_t)m * DM) + F.lane; u32x2* ol = (u32x2*)(HL + (size_t)m * DM) + F.lane;
#pragma unroll
        for (int j = 0; j < 8; ++j) { const int k = 4 * F.lane + 256 * j; const f32x4 gg = *(const f32x4*)(gpre + k), s1 = *(const f32x4*)(mb + 4 * DM + k), s0 = *(const f32x4*)(mb + 3 * DM + k);
            const f32x4 h = v[j] * rs2 * gg * (1.0f + s1) + s0;
            const unsigned h0 = f2bf(h.x), h1 = f2bf(h.y), h2 = f2bf(h.z), h3 = f2bf(h.w);
            oh[64 * j] = (u32x2){h0 | (h1 << 16), h2 | (h3 << 16)};
            ol[64 * j] = (u32x2){pk2(h.x - bf2f(h0), h.y - bf2f(h1)), pk2(h.z - bf2f(h2), h.w - bf2f(h3))}; }
    }
}
__device__ __forceinline__ void p8b_route(Frame& F) {
    const bf16* H = WSP(bf16, WS_H); const bf16* HL = WSP(bf16, WS_H2LO); const bf16* WH = WSP(bf16, WS_WR); const bf16* WL = WH + 64 * DM;
    const float* rbias = INF(28); unsigned* gcnt = WSP(unsigned, WS_CTL) + CW_CNT; int* rowtok = WSP(int, WS_ROWTOK); unsigned* tinfo = WSP(unsigned, WS_TOKINFO); float* tw = (float*)(tinfo + NTOK * 8);
    LAS float* red = (LAS float*)F.lds;
    LAS float* lg = red + 8192;
    LAS int* lcnt = (LAS int*)(lg + 2048);
    LAS int* lbase = lcnt + 64;
    ThinArgs t; t.A[0] = H; t.B[0] = WH; t.A[1] = HL; t.B[1] = WH; t.A[2] = H; t.B[2] = WL;
    for (int blk = F.bid; blk < NTOK / 32; blk += F.G) {
        const int m0 = blk * 32;
        p8_tok<true>(F, m0); VM_WAIT(); __syncthreads();
        if (F.tid < 64) lcnt[F.tid] = 0;
#if OPT_THIN
        thin_mfma_partials<true>(F, H, HL, WH, WL, m0, red);
        __syncthreads();
        { const int row32 = F.tid >> 4, c4 = (F.tid & 15) * 4; *(LAS f32x4*)(lg + row32 * 64 + c4) = thin_reduce4(red, row32, c4); }
        __syncthreads();
#else
        if (F.tid < 256) { const int r = F.tid >> 3, c8 = (F.tid & 7) * 8; float acc[8]; thin_dot8<3>(t, m0 + r, c8, acc);
#pragma unroll
            for (int j = 0; j < 8; ++j) lg[r * 64 + c8 + j] = acc[j]; }
        __syncthreads();
#endif
        int sel_e[4]; int sel_pos[4]; float sel_w[4]; int sel_k[4]; bool sel_f[4];
#pragma unroll
        for (int q = 0; q < 4; ++q) {
            const int r = F.wave * 4 + q, e = F.lane; const float score = 1.0f / (1.0f + expf(-lg[r * 64 + e])); const float sel = score + rbias[e];
            float m1 = sel;
#pragma unroll
            for (int o = 1; o < 8; o <<= 1) m1 = fmaxf(m1, __shfl_xor(m1, o));
            int i1 = (sel == m1) ? e : 64;
#pragma unroll
            for (int o = 1; o < 8; o <<= 1) { const int t2 = __shfl_xor(i1, o); i1 = t2 < i1 ? t2 : i1; }
            float m2 = (e == i1) ? -3.0e38f : sel;
#pragma unroll
            for (int o = 1; o < 8; o <<= 1) m2 = fmaxf(m2, __shfl_xor(m2, o));
            const float gs = m1 + m2; const int g = e >> 3; int grank = 0;
#pragma unroll
            for (int g2 = 0; g2 < 8; ++g2) { const float o = __uint_as_float((unsigned)__builtin_amdgcn_readlane((int)__float_as_uint(gs), g2 * 8)); grank += (o > gs || (o == gs && g2 < g)) ? 1 : 0; }
            const float v = (grank < TOPG) ? sel : -INFINITY; int rank = 0;
#pragma unroll
            for (int e2 = 0; e2 < 64; ++e2) { const float o = __uint_as_float((unsigned)__builtin_amdgcn_readlane((int)__float_as_uint(v), e2)); rank += (o > v || (o == v && e2 < e)) ? 1 : 0; }
            const bool chosen = rank < TOPK; const float wsum = wave_sum(chosen ? score : 0.f);
            const unsigned long long bal = __ballot(chosen); const int kidx = __popcll(bal & ((1ull << e) - 1ull));
            sel_f[q] = chosen; sel_e[q] = e; sel_k[q] = kidx; sel_w[q] = score / wsum * 2.5f; sel_pos[q] = chosen ? __hip_atomic_fetch_add(&lcnt[e], 1, __ATOMIC_RELAXED, __HIP_MEMORY_SCOPE_WORKGROUP) : 0;
        }
        __syncthreads();
        if (F.tid < 64) { const int n = lcnt[F.tid]; lbase[F.tid] = n ? (int)atomicAdd(&gcnt[F.tid], (unsigned)n) : 0; }
        __syncthreads();
#pragma unroll
        for (int q = 0; q < 4; ++q) if (sel_f[q]) { const int tok = m0 + F.wave * 4 + q, e = sel_e[q], pos = lbase[e] + sel_pos[q];
            rowtok[(size_t)e * NTOK + pos] = tok; tinfo[tok * 8 + sel_k[q]] = ((unsigned)e << 16) | (unsigned)pos; tw[tok * 8 + sel_k[q]] = sel_w[q]; }
        __syncthreads();
    }
}
struct P9Row { u32x2 mr[8]; f32x4 xr[8]; };
__device__ __forceinline__ void p9_load(P9Row& R, const bf16* MX, const float* x, int m, int lane) {
    const u32x2* mr = (const u32x2*)(MX + (size_t)m * DM) + lane; const f32x4* xr = (const f32x4*)(x + (size_t)m * DM) + lane;
#pragma unroll
    for (int j = 0; j < 8; ++j) { R.mr[j] = mr[64 * j]; R.xr[j] = xr[64 * j]; }
}
constexpr int LO_PITCH = 4112;
__device__ __forceinline__ void p9_route_lds(Frame& F) {
    const float* x = INF(0); const float* gpost = INF(6); const float* gpre = INF(7); const float* mod = WSP(float, WS_MOD); const bf16* MX = WSP(bf16, WS_MIXED);
    bf16* H = WSP(bf16, WS_H); const bf16* WH = WSP(bf16, WS_WR); const bf16* WL = WH + 64 * DM;
    const float* rbias = INF(28); unsigned* gcnt = WSP(unsigned, WS_CTL) + CW_CNT; int* rowtok = WSP(int, WS_ROWTOK); unsigned* tinfo = WSP(unsigned, WS_TOKINFO); float* tw = (float*)(tinfo + NTOK * 8);
    LAS unsigned char* lo = F.lds;
    LAS unsigned char* hi = F.lds + 16 * LO_PITCH;
    LAS float* red = (LAS float*)hi;
    LAS float* lg = (LAS float*)(F.lds + 32 * LO_PITCH);
    LAS int* lcnt = (LAS int*)(lg + 1024);
    LAS int* lbase = lcnt + 64;
    const int r16 = F.lane & 15, kq = F.lane >> 4;
    for (int blk = F.bid; blk < NTOK / 32; blk += F.G) {
        const int m0 = blk * 32;
        if (F.tid < 64) lcnt[F.tid] = 0;
        int sel_e[4]; int sel_pos[4]; float sel_w[4]; int sel_k[4]; bool sel_f[4];
        P9Row Ra, Rb; p9_load(Ra, MX, x, m0 + 2 * F.wave, F.lane); p9_load(Rb, MX, x, m0 + 2 * F.wave + 1, F.lane);
        const float rb_e = rbias[F.lane];
#pragma unroll
        for (int pass = 0; pass < 2; ++pass) {
            const int r0 = m0 + 16 * pass;
#pragma unroll
            for (int q = 0; q < 2; ++q) {
                const int rl = 2 * F.wave + q, m = r0 + rl, b = m / SEQ;
                const P9Row& R = q ? Rb : Ra;
                int ln = F.lane; asm volatile("" : "+v"(ln));
                f32x4 v[8]; float s1 = 0.f;
#pragma unroll
                for (int j = 0; j < 8; ++j) { const u32x2 w = R.mr[j]; v[j] = (f32x4){__uint_as_float(w.x << 16), __uint_as_float(w.x & 0xffff0000u), __uint_as_float(w.y << 16), __uint_as_float(w.y & 0xffff0000u)}; s1 += (v[j].x * v[j].x + v[j].y * v[j].y) + (v[j].z * v[j].z + v[j].w * v[j].w); }
                const float rs = 1.0f / sqrtf(wave_sum(s1) * (1.0f / DM) + EPS);
                const float* mb = mod + b * 12288; float s2 = 0.f;
#pragma unroll
                for (int hh = 0; hh < 2; ++hh) { f32x4 ggv[4], gtv[4];
#pragma unroll
                    for (int j = 0; j < 4; ++j) { const int k = 4 * ln + 256 * (4 * hh + j); ggv[j] = *(const f32x4*)(gpost + k); gtv[j] = *(const f32x4*)(mb + 2 * DM + k); }
#pragma unroll
                    for (int j4 = 0; j4 < 4; ++j4) { const int j = 4 * hh + j4;
                        v[j] = R.xr[j] + gtv[j4] * (v[j] * rs * ggv[j4]); s2 += (v[j].x * v[j].x + v[j].y * v[j].y) + (v[j].z * v[j].z + v[j].w * v[j].w); } }
                const float rs2 = 1.0f / sqrtf(wave_sum(s2) * (1.0f / DM) + EPS);
                LAS u32x2* ohl = (LAS u32x2*)(hi + rl * LO_PITCH) + ln; LAS u32x2* ol = (LAS u32x2*)(lo + rl * LO_PITCH) + ln;
                unsigned* o8 = (unsigned*)(WSP(unsigned char, WS_H2LO) + (size_t)m * DM) + ln;
#pragma unroll
                for (int hh = 0; hh < 2; ++hh) { f32x4 ggv[4], scv[4], shv[4];
#pragma unroll
                  for (int j = 0; j < 4; ++j) { const int k = 4 * ln + 256 * (4 * hh + j); ggv[j] = *(const f32x4*)(gpre + k); scv[j] = *(const f32x4*)(mb + 4 * DM + k); shv[j] = *(const f32x4*)(mb + 3 * DM + k); }
#pragma unroll
                  for (int j4 = 0; j4 < 4; ++j4) { const int j = 4 * hh + j4;
                    const f32x4 h = v[j] * rs2 * ggv[j4] * (1.0f + scv[j4]) + shv[j4];
                    const unsigned h0 = f2bf(h.x), h1 = f2bf(h.y), h2 = f2bf(h.z), h3 = f2bf(h.w);
                    ohl[64 * j] = (u32x2){h0 | (h1 << 16), h2 | (h3 << 16)};
                    { const unsigned h8 = pk4_fp8(h.x, h.y, h.z, h.w); asm volatile("global_store_dword %0, %1, off" : : "v"(o8 + 64 * j), "v"(h8) : "memory"); }
                    ol[64 * j] = (u32x2){pk2(h.x - bf2f(h0), h.y - bf2f(h1)), pk2(h.z - bf2f(h2), h.w - bf2f(h3))}; } }
            }
            LDS_WAIT(); __builtin_amdgcn_s_barrier();
            { f32x4 acc[4];
#pragma unroll
              for (int cb = 0; cb < 4; ++cb) acc[cb] = (f32x4){0.f, 0.f, 0.f, 0.f};
              const size_t aoff = (size_t)(F.bid * 16 + r16) * DM + 256 * F.wave + 8 * kq, boff = (size_t)r16 * DM + 256 * F.wave + 8 * kq;
              const LAS unsigned char* lrow = lo + r16 * LO_PITCH + (256 * F.wave + 8 * kq) * 2; const LAS unsigned char* hrow = hi + r16 * LO_PITCH + (256 * F.wave + 8 * kq) * 2;
#pragma unroll 1
              for (int kg = 0; kg < 8; kg += 2) {
                  bf16x8 ah[2], al[2], bh[2][4], bl[2][4];
#pragma unroll
                  for (int q = 0; q < 2; ++q) { const int ks = kg + q; ah[q] = *(const LAS bf16x8*)(hrow + 64 * ks); al[q] = *(const LAS bf16x8*)(lrow + 64 * ks);
#pragma unroll
                      for (int cb = 0; cb < 4; ++cb) { const size_t fo = ((size_t)((F.wave * 8 + ks) * 4 + cb) * 64 + F.lane) * 8; bh[q][cb] = *(const bf16x8*)(WH + fo); bl[q][cb] = *(const bf16x8*)(WL + fo); } }
                  __builtin_amdgcn_sched_barrier(0);
#pragma unroll
                  for (int q = 0; q < 2; ++q)
#pragma unroll
                      for (int cb = 0; cb < 4; ++cb) {
                          acc[cb] = __builtin_amdgcn_mfma_f32_16x16x32_bf16(ah[q], bh[q][cb], acc[cb], 0, 0, 0);
                          acc[cb] = __builtin_amdgcn_mfma_f32_16x16x32_bf16(al[q], bh[q][cb], acc[cb], 0, 0, 0);
                          acc[cb] = __builtin_amdgcn_mfma_f32_16x16x32_bf16(ah[q], bl[q][cb], acc[cb], 0, 0, 0); }
                  __builtin_amdgcn_sched_barrier(0);
              }
              LDS_WAIT(); __builtin_amdgcn_s_barrier();
              if (pass == 0) { p9_load(Ra, MX, x, m0 + 16 + 2 * F.wave, F.lane); p9_load(Rb, MX, x, m0 + 16 + 2 * F.wave + 1, F.lane); }
#pragma unroll
              for (int cb = 0; cb < 4; ++cb)
#pragma unroll
                  for (int rg = 0; rg < 4; ++rg) red[(F.wave * 16 + 4 * kq + rg) * 64 + cb * 16 + r16] = acc[cb][rg]; }
            LDS_WAIT(); __builtin_amdgcn_s_barrier();
            { const int row = F.tid >> 5, c2 = (F.tid & 31) * 2; float s0 = 0.f, s1 = 0.f;
#pragma unroll
              for (int w = 0; w < 8; ++w) { const f32x2 t = *(const LAS f32x2*)(red + (w * 16 + row) * 64 + c2); s0 += t.x; s1 += t.y; }
              *(LAS f32x2*)(lg + row * 64 + c2) = (f32x2){s0, s1}; }
            LDS_WAIT(); __builtin_amdgcn_s_barrier();
#pragma unroll
            for (int q2 = 0; q2 < 2; ++q2) {
                const int q = 2 * pass + q2;
                const int r = F.wave * 2 + q2, e = F.lane; const float score = 1.0f / (1.0f + expf(-lg[r * 64 + e])); const float sel = score + rb_e;
                float m1 = sel;
                m1 = fmaxf(m1, dppf<DPP_X1>(m1)); m1 = fmaxf(m1, dppf<DPP_X2>(m1)); m1 = fmaxf(m1, dppf<DPP_HM>(m1));
                int i1 = (sel == m1) ? e : 64;
                { int t2 = dppi<DPP_X1>(i1); i1 = t2 < i1 ? t2 : i1; t2 = dppi<DPP_X2>(i1); i1 = t2 < i1 ? t2 : i1; t2 = dppi<DPP_HM>(i1); i1 = t2 < i1 ? t2 : i1; }
                float m2 = (e == i1) ? -3.0e38f : sel;
                m2 = fmaxf(m2, dppf<DPP_X1>(m2)); m2 = fmaxf(m2, dppf<DPP_X2>(m2)); m2 = fmaxf(m2, dppf<DPP_HM>(m2));
                const float gs = m1 + m2; const int g = e >> 3; int grank = 0;
#pragma unroll
                for (int g2 = 0; g2 < 8; ++g2) { const float o = __uint_as_float((unsigned)__builtin_amdgcn_readlane((int)__float_as_uint(gs), g2 * 8)); grank += (o > gs || (o == gs && g2 < g)) ? 1 : 0; }
                const float v = (grank < TOPG) ? sel : -INFINITY; int rank = 0;
#pragma unroll
                for (int e2 = 0; e2 < 64; ++e2) { const float o = __uint_as_float((unsigned)__builtin_amdgcn_readlane((int)__float_as_uint(v), e2)); rank += (o > v || (o == v && e2 < e)) ? 1 : 0; }
                const bool chosen = rank < TOPK; const float wsum = wave_sum(chosen ? score : 0.f);
                const unsigned long long bal = __ballot(chosen); const int kidx = __popcll(bal & ((1ull << e) - 1ull));
                sel_f[q] = chosen; sel_e[q] = e; sel_k[q] = kidx; sel_w[q] = score / wsum * 2.5f; sel_pos[q] = chosen ? __hip_atomic_fetch_add(&lcnt[e], 1, __ATOMIC_RELAXED, __HIP_MEMORY_SCOPE_WORKGROUP) : 0;
            }
            LDS_WAIT(); __builtin_amdgcn_s_barrier();
        }
        if (F.tid < 64) { const int n = lcnt[F.tid]; lbase[F.tid] = n ? (int)atomicAdd(&gcnt[F.tid], (unsigned)n) : 0; }
        __syncthreads();
#pragma unroll
        for (int q = 0; q < 4; ++q) if (sel_f[q]) { const int tok = m0 + 16 * (q >> 1) + F.wave * 2 + (q & 1), e = sel_e[q], pos = lbase[e] + sel_pos[q];
            rowtok[(size_t)e * NTOK + pos] = tok; tinfo[tok * 8 + sel_k[q]] = ((unsigned)e << 16) | (unsigned)pos; tw[tok * 8 + sel_k[q]] = sel_w[q]; }
        __syncthreads();
    }
}
__device__ __forceinline__ f32x4 dec4_fp8(unsigned q) { const f32x2 lo = __builtin_amdgcn_cvt_pk_f32_fp8((int)q, false), hi = __builtin_amdgcn_cvt_pk_f32_fp8((int)q, true); return (f32x4){lo.x, lo.y, hi.x, hi.y}; }
__device__ __forceinline__ void p11_out(Frame& F, const MoeTab& T) {
    const int gw = F.bid * NWAVES + F.wave, NGW = F.G * NWAVES;
    const float* gpost = INF(8); const float* mod = WSP(float, WS_MOD); const unsigned char* Y = WSP(unsigned char, WS_Y); const unsigned char* YS = WSP(unsigned char, WS_YS);
    const unsigned* tinfo = WSP(unsigned, WS_TOKINFO); const float* tw = (const float*)(tinfo + NTOK * 8);
    for (int m = gw; m < NTOK; m += NGW) {
        const int b = m / SEQ;
        int ln = F.lane; asm volatile("" : "+v"(ln));
        const unsigned inf_l = tinfo[m * 8 + (ln & 7)]; const float w_l = tw[m * 8 + (ln & 7)];
        unsigned yv[TOPK][8]; float wk[TOPK];
#pragma unroll
        for (int k = 0; k < TOPK; ++k) { const unsigned inf = (unsigned)__builtin_amdgcn_readlane((int)inf_l, k); wk[k] = __uint_as_float((unsigned)__builtin_amdgcn_readlane((int)__float_as_uint(w_l), k)) * (1.0f / Y_SCALE);
            const int e = inf >> 16, pos = inf & 0xffff; const size_t slot = (size_t)T.mtoff[e] * 256 + pos; const unsigned* yr = (const unsigned*)(Y + slot * DM) + ln;
#pragma unroll
            for (int j = 0; j < 8; ++j) yv[k][j] = yr[64 * j]; }
        unsigned sv[8]; f32x4 xv[8]; u32x2 mv[8];
        { const unsigned* ys = (const unsigned*)(YS + (size_t)m * DM) + ln; const f32x4* xi = (const f32x4*)(INF(0) + (size_t)m * DM) + ln; const u32x2* mr = (const u32x2*)(WSP(bf16, WS_MIXED) + (size_t)m * DM) + ln;
#pragma unroll
          for (int j = 0; j < 8; ++j) { sv[j] = ys[64 * j]; xv[j] = xi[64 * j]; mv[j] = mr[64 * j]; } }
        { float s1 = 0.f;
#define MX_UNPACK(w) ((f32x4){__uint_as_float((w).x << 16), __uint_as_float((w).x & 0xffff0000u), __uint_as_float((w).y << 16), __uint_as_float((w).y & 0xffff0000u)})
#pragma unroll
          for (int j = 0; j < 8; ++j) { const f32x4 mx = MX_UNPACK(mv[j]); s1 += (mx.x * mx.x + mx.y * mx.y) + (mx.z * mx.z + mx.w * mx.w); }
          const float rs1 = 1.0f / sqrtf(wave_sum(s1) * (1.0f / DM) + EPS); const float* gp1 = INF(6); const float* gt1 = mod + b * 12288 + 2 * DM;
#pragma unroll
          for (int j = 0; j < 8; ++j) { const int k = 4 * ln + 256 * j; const f32x4 gg = *(const f32x4*)(gp1 + k), gt = *(const f32x4*)(gt1 + k); const f32x4 mx = MX_UNPACK(mv[j]); xv[j] = xv[j] + gt * (mx * rs1 * gg); } }
#undef MX_UNPACK
        f32x4 acc[8];
#pragma unroll
        for (int j = 0; j < 8; ++j) acc[j] = dec4_fp8(sv[j]) * (1.0f / Y_SCALE);
#pragma unroll
        for (int k = 0; k < TOPK; ++k)
#pragma unroll
            for (int j = 0; j < 8; ++j) acc[j] += wk[k] * dec4_fp8(yv[k][j]);
        float s2 = 0.f;
#pragma unroll
        for (int j = 0; j < 8; ++j) s2 += (acc[j].x * acc[j].x + acc[j].y * acc[j].y) + (acc[j].z * acc[j].z + acc[j].w * acc[j].w);
        const float rs = 1.0f / sqrtf(wave_sum(s2) * (1.0f / DM) + EPS);
        const float* gt2 = mod + b * 12288 + 5 * DM; f32x4* xo = (f32x4*)(F.out + (size_t)m * DM) + ln;
        __builtin_amdgcn_sched_barrier(0);
#pragma unroll
        for (int hh = 0; hh < 2; ++hh) { f32x4 gg2[4], gtv[4];
#pragma unroll
            for (int j = 0; j < 4; ++j) { const int k = 4 * ln + 256 * (4 * hh + j); gg2[j] = *(const f32x4*)(gpost + k); gtv[j] = *(const f32x4*)(gt2 + k); }
#pragma unroll
            for (int j = 0; j < 4; ++j) xo[64 * (4 * hh + j)] = xv[4 * hh + j] + gtv[j] * (acc[4 * hh + j] * rs * gg2[j]); }
    }
}

constexpr int NPHASE = 13;
__global__ void __launch_bounds__(NTHR, 2) mk_fwd(Args args) {
    extern __shared__ __attribute__((aligned(16))) unsigned char lds_raw[];
    Frame F; F.lds = (LAS unsigned char*)lds_raw; F.ws = args.ws; F.in = args.in; F.out = args.out;
    F.tid = threadIdx.x; F.lane = F.tid & 63; F.wave = __builtin_amdgcn_readfirstlane(F.tid >> 6); F.G = gridDim.x; F.bid = blockIdx.x; F.vcu = (F.G % 8 == 0) ? (F.bid % 8) * (F.G / 8) + F.bid / 8 : F.bid;
    volatile LAS unsigned* MISC = (volatile LAS unsigned*)(F.lds + MISC_OFF);
    if (F.tid < 64) MISC[F.tid] = 0u;
    __syncthreads();
    const int lo = args.ph_lo, hi = args.ph_hi;
    XcdBarrier bar; bar.bar = WSP(unsigned, WS_CTL) + CW_BAR; bar.x = 0; bar.st = MISC + 8;
    if (hi - lo > 1) bar = xcd_barrier_post(WSP(unsigned, WS_CTL) + CW_BAR, MISC + 8);
#ifndef REP_PHASE
#define REP_PHASE -1
#endif
#define IN(k) (lo <= (k) && (k) < hi)
#ifndef WAITPROBE
#define WAITPROBE -1
#endif
    unsigned long long wp_acc = 0ull;
#define SEAM(k) do { if (IN(k) && IN((k) + 1)) { unsigned long long wp_t0 = 0ull; if (WAITPROBE >= 0) wp_t0 = __builtin_amdgcn_s_memrealtime(); xcd_barrier(bar); \
        if (WAITPROBE == (k) || WAITPROBE == 99) wp_acc += __builtin_amdgcn_s_memrealtime() - wp_t0; } } while (0)
    MoeTab MT; MT.mtoff = (LAS int*)(F.lds + MISC_OFF + 256); MT.cnt = MT.mtoff + 72;

#define RUN(id, ...) do { __VA_ARGS__; if (REP_PHASE == (id)) { __syncthreads(); __VA_ARGS__; __syncthreads(); } } while (0)
    if (IN(0)) { RUN(0, p0_mod(F); p0_small(F); p0_transposes<false>(F)); } SEAM(0);
    if (IN(1)) { RUN(1, p1_h1(F)); } SEAM(1);
    if (IN(2)) { GridSched S; S.init(WSP(bf16, WS_H), DM, WSP(bf16, WS_WIN), DM, NTOK, 2048, F.G, F.bid);
        GridSched S8; S8.init(WSP(bf16, WS_H2LO), DM / 2, (const bf16*)(WSP(unsigned char, WS_H2LO) + 16 * MiB), DM / 2, NTOK, 4096, F.G, F.bid);
        EpiG1 E{WSP(bf16, WS_QL), WSP(bf16, WS_KVL), WSP(bf16, WS_U), WSP(bf16, WS_SGM), WSP(bf16, WS_SGS), WSP(float, WS_RSS), 0};
        EpiG1 E8{WSP(bf16, WS_QL), WSP(bf16, WS_KVL), WSP(bf16, WS_U), WSP(bf16, WS_SGM), WSP(bf16, WS_SGS), WSP(float, WS_RSS), 8};
        if (F.vcu & 1) { p0_transposes<true>(F); __syncthreads(); }
        RUN(2, gemm_run<false>(F, S, E)); __syncthreads();
        gemm_run<false, false, E8_GU_W, E8_ONE>(F, S8, E8);
        if (!(F.vcu & 1)) { __syncthreads(); p0_transposes<true>(F); } } SEAM(2);
    if (IN(3)) { P3Sched S{WSP(bf16, WS_QL), WSP(bf16, WS_KVL), WSP(bf16, WS_WUQ), WSP(bf16, WS_WUKV), 512, 512, F.G, F.vcu};
        EpiP3 E{WSP(bf16, WS_Q), WSP(bf16, WS_KN), WSP(bf16, WS_VT), WSP(float, WS_RSS), WSP(f32x2, WS_ROPE)};
        RUN(30, gemm_run<false>(F, S, E)); __syncthreads();
        RUN(31, p3_kpe_mfma(F)); __syncthreads();
        RUN(32, s5_fused(F)); } SEAM(3);
    if (IN(4)) { RUN(40, att3::attn_phase(F)); __syncthreads();
        GluSched S{WSP(bf16, WS_YG), WSP(bf16, WS_WGLU), 1024, 1024, F.G, F.vcu};
        EpiMix E{WSP(bf16, WS_M1), WSP(bf16, WS_S5O), WSP(bf16, WS_SGM), WSP(bf16, WS_SGS), WSP(bf16, WS_YG)};
        gemm_run<false, true>(F, S, E); } SEAM(4);
    if (IN(5)) { PairSched S{WSP(bf16, WS_AO), WSP(bf16, WS_WBRM), WSP(bf16, WS_S5O), WSP(bf16, WS_WBRS), 1024, 1024, F.G, F.vcu};
        EpiMix E{WSP(bf16, WS_M1), WSP(bf16, WS_S5O), WSP(bf16, WS_SGM), WSP(bf16, WS_SGS), WSP(bf16, WS_YG)};
        RUN(5, gemm_run<false>(F, S, E)); } SEAM(6);
    if (IN(7)) { GridSched S; S.init(WSP(bf16, WS_M1), DM, WSP(bf16, WS_WOUT), DM, NTOK, DM, F.G, F.bid);
        EpiBf16Plain E{WSP(bf16, WS_MIXED), DM}; RUN(7, gemm_run<false>(F, S, E)); } SEAM(7);
    if (IN(9)) { p9_route_lds(F); } SEAM(9);
    if (IN(10)) { moe_build_tab(F, MT);
        MoeSched<4, false> S{MT, WSP(bf16, WS_H2LO), nullptr, WSP(bf16, WS_WGU), WSP(int, WS_ROWTOK), DM / 2, DM / 2, F.G, F.vcu};
        EpiGU E{WSP(bf16, WS_ACT), WSP(bf16, WS_ACTS)}; RUN(10, gemm_run<true, true, E8_GU_W, E8_ONE>(F, S, E)); } SEAM(10);
    if (IN(11)) { if (lo == 11) moe_build_tab(F, MT);
        MoeSched<8, true> S{MT, WSP(bf16, WS_ACT), WSP(bf16, WS_ACTS), WSP(bf16, WS_WD), nullptr, DE / 2, DE / 2, F.G, F.vcu};
        EpiDown E{WSP(bf16, WS_Y), WSP(bf16, WS_YS)}; RUN(11, gemm_run<false, true, E8_DN_W, E8_ACT>(F, S, E)); } SEAM(11);
    if (IN(12)) { if (lo == 12) moe_build_tab(F, MT); p11_out(F, MT); }
    if (REP_PHASE == 99 && hi - lo > 1) { for (int q = 0; q < 10; ++q) xcd_barrier(bar); }
    if (WAITPROBE >= 0 && hi - lo > 1) {
        unsigned* wp = WSP(unsigned, WS_CTL) + 12288;
        if (F.tid == 0) atomicAdd(wp, (unsigned)wp_acc);
        xcd_barrier(bar);
        if (F.bid == 0 && F.tid == 0) { const unsigned sum = __hip_atomic_load(wp, __ATOMIC_RELAXED, __HIP_MEMORY_SCOPE_AGENT); const unsigned long long dl = (unsigned long long)sum * 16ull / (unsigned)F.G;
            const unsigned long long t0 = __builtin_amdgcn_s_memrealtime(); while (__builtin_amdgcn_s_memrealtime() - t0 < dl) __builtin_amdgcn_s_sleep(8); }
    }
}

extern "C" void kernel_launch(void* const* d_in, const int* in_sizes, int n_in, void* d_out, int out_size, void* d_ws, size_t ws_size, hipStream_t stream) {
    static int grid = 0;
    if (!grid) {
        if (n_in != 35 || out_size != NTOK * DM || ws_size < WS_END) { fprintf(stderr, "kernel_launch: unexpected problem (n_in %d out %d ws %zu, need %zu)\n", n_in, out_size, ws_size, (size_t)WS_END); }
        int dev = 0, cus = 0, per_cu = 0;
        (void)hipGetDevice(&dev); (void)hipDeviceGetAttribute(&cus, hipDeviceAttributeMultiprocessorCount, dev);
        (void)hipFuncSetAttribute((const void*)mk_fwd, hipFuncAttributeMaxDynamicSharedMemorySize, LDS_BYTES);
        (void)hipOccupancyMaxActiveBlocksPerMultiprocessor(&per_cu, (const void*)mk_fwd, NTHR, LDS_BYTES);
        if (per_cu < 1) fprintf(stderr, "kernel_launch: occupancy query says %d blocks per CU\n", per_cu);
        grid = cus > 0 ? cus : 256;
    }
    (void)hipMemsetAsync((char*)d_ws + WS_CTL, 0, CTL_ZERO_BYTES, stream);
    Args a{};
    for (int i = 0; i < 35; ++i) a.in[i] = d_in[i];
    a.out = (float*)d_out; a.ws = (unsigned char*)d_ws;
#if MK_ONE_LAUNCH
    a.ph_lo = 0; a.ph_hi = NPHASE;
    hipLaunchKernelGGL(mk_fwd, dim3(grid), dim3(NTHR), LDS_BYTES, stream, a);
#else
    for (int p = 0; p < NPHASE; ++p) { a.ph_lo = p; a.ph_hi = p + 1; hipLaunchKernelGGL(mk_fwd, dim3(grid), dim3(NTHR), LDS_BYTES, stream, a); }
#endif
}
```
